# Optimizing an MI355X kernel written in HIP

```python
import math
import jax, jax.numpy as jnp
from jax import lax
import numpy as np

D_MODEL = 1024
BATCH = 4
SEQ = 4096
DEPTH = 2

PLE_DIM = 256

A_WIDTH = D_MODEL // 4
A_DK = 64
A_DV = 64
A_HEADS = A_WIDTH // A_DV
A_CHUNK = 16

B_WIDTH = D_MODEL // 4
B_CH = 64
B_GROUPS = B_WIDTH // B_CH
B_CHUNK = 128

C_WIDTH = D_MODEL // 2
C_NOPE = 64
C_ROPE = 32
C_V = 64
C_HEADS = C_WIDTH // C_V
C_Q_RANK = 384
C_KV_RANK = 256
Q_BLOCK = 128
ROPE_THETA = 10000.0

MIX_WIDTH = A_WIDTH + B_WIDTH + C_WIDTH
IN_SIZES = (A_WIDTH, A_WIDTH, A_WIDTH, A_WIDTH, B_WIDTH, B_WIDTH, C_Q_RANK, C_KV_RANK, C_ROPE)
IN_COLS = sum(IN_SIZES)
IN_SPLITS = tuple(int(s) for s in np.cumsum(IN_SIZES)[:-1])

D_FF = int(math.ceil(8 * D_MODEL / 3 / 256)) * 256
LN_EPS = 1e-5
RMS_EPS = 1e-6
DEEPNORM_ALPHA = (2 * DEPTH) ** 0.25
DEEPNORM_BETA = (8 * DEPTH) ** -0.25

kernel_name = "hybrid_hgrn2_sgu_mla_deepnorm"


def layer_norm(x, g, b):
    xf = x.astype(jnp.float32)
    mu = jnp.mean(xf, -1, keepdims=True)
    var = jnp.mean(jnp.square(xf - mu), -1, keepdims=True)
    return ((xf - mu) * lax.rsqrt(var + LN_EPS)).astype(x.dtype) * g + b


def rms_norm(x, g):
    xf = x.astype(jnp.float32)
    y = xf * lax.rsqrt(jnp.mean(xf * xf, -1, keepdims=True) + RMS_EPS)
    return y.astype(x.dtype) * g


def rope(x, cos, sin):
    x1, x2 = jnp.split(x, 2, axis=-1)
    return jnp.concatenate([x1 * cos - x2 * sin, x2 * cos + x1 * sin], axis=-1).astype(x.dtype)


def hgrn2_mixer(q, f_logit, i_in, g, lb, norm_g):
    bsz, s, _ = q.shape
    n = s // A_CHUNK
    f32 = jnp.float32

    def heads(t):
        return t.astype(f32).reshape(bsz, n, A_CHUNK, A_HEADS, -1)

    lbf = lb.astype(f32)
    f = lbf + (1.0 - lbf) * jax.nn.sigmoid(f_logit.astype(f32))
    qh = heads(jax.nn.silu(q.astype(f32)))
    kh = heads(1.0 - f)
    vh = heads(i_in)
    bcum = jnp.cumsum(heads(jnp.log(f)), axis=2)

    causal = jnp.tril(jnp.ones((A_CHUNK, A_CHUNK), dtype=bool))[None, None, :, :, None, None]
    diff = bcum[:, :, :, None] - bcum[:, :, None, :]
    decay = jnp.exp(jnp.where(causal, diff, -jnp.inf))
    scores = jnp.einsum('bnthk,bnshk,bntshk->bnhts', qh, kh, decay)
    o_intra = jnp.einsum('bnhts,bnshv->bnthv', scores, vh)

    b_last = bcum[:, :, -1]
    k_to_end = kh * jnp.exp(b_last[:, :, None] - bcum)
    chunk_kv = jnp.einsum('bnshk,bnshv->bnhkv', k_to_end, vh)
    chunk_decay = jnp.exp(b_last)

    def step(state, xs):
        dec, kv = xs
        return dec[..., None] * state + kv, state

    init = jnp.zeros((bsz, A_HEADS, A_DK, A_DV), f32)
    _, prev_states = lax.scan(step, init, (jnp.moveaxis(chunk_decay, 1, 0), jnp.moveaxis(chunk_kv, 1, 0)))
    prev_states = jnp.moveaxis(prev_states, 0, 1)
    o_inter = jnp.einsum('bnthk,bnhkv->bnthv', qh * jnp.exp(bcum), prev_states)

    o = (o_intra + o_inter).reshape(bsz, s, A_HEADS, A_DV)
    o = o * lax.rsqrt(jnp.mean(o * o, -1, keepdims=True) + RMS_EPS)
    o = o.reshape(bsz, s, A_WIDTH) * norm_g.astype(f32) * jax.nn.silu(g.astype(f32))
    return o.astype(g.dtype)


def sgu_mixer(u, v, ln_g, ln_b, w_s, b_s):
    bsz, s, _ = u.shape
    n = s // B_CHUNK
    u = jax.nn.gelu(u, approximate=False)
    v = layer_norm(jax.nn.gelu(v, approximate=False), ln_g, ln_b)
    vh = v.reshape(bsz, n, B_CHUNK, B_GROUPS, B_CH)
    w = w_s * jnp.tril(jnp.ones((B_CHUNK, B_CHUNK), dtype=w_s.dtype))
    z = jnp.einsum('gts,bnsgc->bntgc', w, vh) + b_s.T[None, None, :, :, None]
    return u * z.reshape(bsz, s, B_WIDTH)


def mla_mixer(c_q, c_kv, k_rope_raw, cos, sin, q_norm_g, w_uq, kv_norm_g, w_ukv):
    bsz, s, _ = c_q.shape
    q = (rms_norm(c_q, q_norm_g) @ w_uq).reshape(bsz, s, C_HEADS, C_NOPE + C_ROPE)
    q_nope = q[..., :C_NOPE]
    q_rope = rope(q[..., C_NOPE:], cos[:, :, None], sin[:, :, None])
    kv = (rms_norm(c_kv, kv_norm_g) @ w_ukv).reshape(bsz, s, C_HEADS, C_NOPE + C_V)
    k_nope, v = kv[..., :C_NOPE], kv[..., C_NOPE:]
    k_rope = rope(k_rope_raw, cos, sin)

    nb = s // Q_BLOCK
    scale = (C_NOPE + C_ROPE) ** -0.5
    key_idx = jnp.arange(s)

    def blocks(t):
        return jnp.moveaxis(t.reshape(bsz, nb, Q_BLOCK, *t.shape[2:]), 1, 0)

    def attend(args):
        qn, qr, blk = args
        sc = jnp.einsum('bqhd,bkhd->bhqk', qn, k_nope) + jnp.einsum('bqhr,bkr->bhqk', qr, k_rope)
        sc = sc.astype(jnp.float32) * scale
        q_idx = blk * Q_BLOCK + jnp.arange(Q_BLOCK)
        sc = jnp.where(key_idx[None, :] <= q_idx[:, None], sc, -jnp.inf)
        pr = jax.nn.softmax(sc, axis=-1).astype(v.dtype)
        return jnp.einsum('bhqk,bkhv->bqhv', pr, v)

    out = lax.map(attend, (blocks(q_nope), blocks(q_rope), jnp.arange(nb)))
    return jnp.moveaxis(out, 0, 1).reshape(bsz, s, C_WIDTH)


def setup_inputs(seed: int = 0) -> dict:
    key = jax.random.key(seed)
    ks = jax.random.split(key, 32)
    f32 = jnp.float32

    def nrm(k, shape, scale):
        return jax.random.normal(k, shape, f32) * scale

    def gain(k, shape):
        return 1.0 + 0.02 * jax.random.normal(k, shape, f32)

    positions = (jnp.arange(SEQ, dtype=jnp.int32)[None, :]
                 + jax.random.randint(ks[2], (BATCH, 1), 0, 64, dtype=jnp.int32))
    return {
        "x": nrm(ks[0], (BATCH, SEQ, D_MODEL), 1.0),
        "p": nrm(ks[1], (DEPTH, BATCH, SEQ, PLE_DIM), 1.0),
        "positions": positions,
        "ln_in_g": gain(ks[3], (D_MODEL,)),
        "ln_in_b": nrm(ks[4], (D_MODEL,), 0.02),
        "w_in": nrm(ks[5], (DEPTH, D_MODEL, IN_COLS), D_MODEL ** -0.5),
        "hgrn_lb_logits": nrm(ks[6], (DEPTH, A_WIDTH), 0.5),
        "hgrn_norm_g": gain(ks[7], (DEPTH, A_WIDTH)),
        "sgu_ln_g": gain(ks[8], (DEPTH, B_WIDTH)),
        "sgu_ln_b": nrm(ks[9], (DEPTH, B_WIDTH), 0.02),
        "sgu_w_s": nrm(ks[10], (DEPTH, B_GROUPS, B_CHUNK, B_CHUNK), B_CHUNK ** -0.5),
        "sgu_b_s": gain(ks[11], (DEPTH, B_GROUPS, B_CHUNK)),
        "mla_q_norm_g": gain(ks[12], (DEPTH, C_Q_RANK)),
        "mla_w_uq": nrm(ks[13], (DEPTH, C_Q_RANK, C_HEADS * (C_NOPE + C_ROPE)), C_Q_RANK ** -0.5),
        "mla_kv_norm_g": gain(ks[14], (DEPTH, C_KV_RANK)),
        "mla_w_ukv": nrm(ks[15], (DEPTH, C_KV_RANK, C_HEADS * (C_NOPE + C_V)), C_KV_RANK ** -0.5),
        "w_out": nrm(ks[16], (DEPTH, MIX_WIDTH, D_MODEL), DEEPNORM_BETA * MIX_WIDTH ** -0.5),
        "ln1_g": gain(ks[17], (DEPTH, D_MODEL)),
        "ln1_b": nrm(ks[18], (DEPTH, D_MODEL), 0.02),
        "w_gate_up": nrm(ks[19], (DEPTH, D_MODEL, 2 * D_FF), D_MODEL ** -0.5),
        "w_down": nrm(ks[20], (DEPTH, D_FF, D_MODEL), DEEPNORM_BETA * D_FF ** -0.5),
        "ple_w_gate": nrm(ks[21], (DEPTH, D_MODEL, D_MODEL), D_MODEL ** -0.5),
        "ple_w_proj": nrm(ks[22], (DEPTH, PLE_DIM, D_MODEL), DEEPNORM_BETA * PLE_DIM ** -0.5),
        "ln2_g": gain(ks[23], (DEPTH, D_MODEL)),
        "ln2_b": nrm(ks[24], (DEPTH, D_MODEL), 0.02),
    }


def reference(x, p, positions, ln_in_g, ln_in_b, w_in, hgrn_lb_logits, hgrn_norm_g,
              sgu_ln_g, sgu_ln_b, sgu_w_s, sgu_b_s, mla_q_norm_g, mla_w_uq,
              mla_kv_norm_g, mla_w_ukv, w_out, ln1_g, ln1_b, w_gate_up, w_down,
              ple_w_gate, ple_w_proj, ln2_g, ln2_b):
    lb_cum = jnp.cumsum(jax.nn.softmax(hgrn_lb_logits.astype(jnp.float32), axis=0), axis=0)
    lower_bounds = lb_cum - lb_cum[0]

    inv_freq = ROPE_THETA ** (-jnp.arange(0, C_ROPE, 2, dtype=jnp.float32) / C_ROPE)
    ang = positions.astype(jnp.float32)[..., None] * inv_freq
    cos, sin = jnp.cos(ang), jnp.sin(ang)

    h = layer_norm(x, ln_in_g, ln_in_b)
    for i in range(DEPTH):
        proj = h @ w_in[i]
        a_q, a_f, a_i, a_g, b_u, b_v, c_q, c_kv, c_kr = jnp.split(proj, IN_SPLITS, axis=-1)
        o_a = hgrn2_mixer(a_q, a_f, a_i, a_g, lower_bounds[i], hgrn_norm_g[i])
        o_b = sgu_mixer(b_u, b_v, sgu_ln_g[i], sgu_ln_b[i], sgu_w_s[i], sgu_b_s[i])
        o_c = mla_mixer(c_q, c_kv, c_kr, cos, sin, mla_q_norm_g[i], mla_w_uq[i],
                        mla_kv_norm_g[i], mla_w_ukv[i])
        mix = jnp.concatenate([o_a, o_b, o_c], axis=-1) @ w_out[i]
        h = layer_norm(DEEPNORM_ALPHA * h + mix, ln1_g[i], ln1_b[i])

        gate, up = jnp.split(h @ w_gate_up[i], 2, axis=-1)
        ffn = (jax.nn.silu(gate) * up) @ w_down[i]
        ple = jax.nn.sigmoid(h @ ple_w_gate[i]) * (p[i] @ ple_w_proj[i])
        h = layer_norm(DEEPNORM_ALPHA * h + ffn + ple, ln2_g[i], ln2_b[i])
    return h
```

```cpp
#include <hip/hip_runtime.h>
#include <hip/hip_cooperative_groups.h>
#include <cstdio>
#include <cstdint>
namespace cg = cooperative_groups;
__device__ __forceinline__ int tid_(int wv);
namespace pg8 {
#define PG8_LAS __attribute__((address_space(3)))
typedef unsigned short bf16_t;
typedef short bf16x8 __attribute__((ext_vector_type(8)));
typedef float f32x4 __attribute__((ext_vector_type(4)));
typedef unsigned u32x4 __attribute__((ext_vector_type(4)));
constexpr int BM = 256, BK = 64, HALF = 128, HTB = HALF * BK * 2  , STAGE_BYTES = 8 * HTB, NXCD = 8, WGM = 8;

__host__ __device__ __forceinline__ int lds_byte(int r, int c) { const int st = (r >> 4) * 2 + (c >> 5), rr = r & 15, cc = c & 31, ob = rr * 64 + cc * 2; return st * 1024 + (ob ^ (((ob >> 9) & 1) << 5)); }
__host__ __device__ __forceinline__ void stage_rc(int b, int& R, int& C) { const int st = b / 1024, sb = b % 1024, swz = sb ^ (((sb >> 9) & 1) << 5); R = (st >> 1) * 16 + swz / 64; C = (st & 1) * 32 + (swz % 64) / 2; }
__host__ __device__ __forceinline__ int perm32(int rho) { const int n = rho >> 4, i = rho & 15; return 8 * (i >> 2) + 4 * n + (i & 3); }

struct Unit { int pm, pn; };
struct Gemm { const bf16_t* A; const bf16_t* Bt; int M, N, K; };

struct StaticOrder {
    int nM, nN, nwg, G, c;
    __host__ __device__ void init(int M, int N, int G_, int c_) { nM = M / BM; nN = N / BM; nwg = nM * nN; G = G_; c = c_; }
    __host__ __device__ bool next(int i, Unit& u) const {
        const long L = (long)i * G + c; if (L >= nwg) return false;
        int wgid = (int)L; { const int q = nwg / NXCD, r = nwg % NXCD, xcd = wgid % NXCD, off = wgid / NXCD; wgid = (xcd < r ? xcd * (q + 1) : r * (q + 1) + (xcd - r) * q) + off; }
        const int nig = WGM * nN, gid = wgid / nig, fm = gid * WGM, gsz = (nM - fm) < WGM ? (nM - fm) : WGM;
        u.pm = fm + ((wgid % nig) % gsz); u.pn = (wgid % nig) / gsz; return true;
    }
    __device__ __forceinline__ void a_ready(const Unit&) const {}
    __device__ __forceinline__ void done(const Unit&) const {}
};

template <class Epi, class Sched>
__device__ __forceinline__ void gemm_phase(PG8_LAS unsigned char* lds, const Gemm g, const Sched& S, const Epi& E, int wv) {
    const int tid = tid_(wv), wid = __builtin_amdgcn_readfirstlane(tid >> 6), lane = tid & 63, wr = wid >> 2, wc = wid & 3, fr = lane & 15, fq = lane >> 4;
    const int K = g.K, nt = K / BK;
    unsigned voffA[2], voffB[2];
#pragma unroll
    for (int i = 0; i < 2; ++i) { int R, C; stage_rc(tid * 16 + i * 8192, R, C); const int Rb = Epi::PERM ? ((R & ~31) + perm32(R & 31)) : R;
        voffA[i] = (unsigned)(R * K + C) * 2u; voffB[i] = (unsigned)(Rb * K + C) * 2u; }
    const size_t kstep = (size_t)(BK * 2);
    const size_t hstep = (size_t)HALF * K * 2;
    const size_t tstep = 2 * hstep;
    const unsigned ldsw = (unsigned)wid * 1024u;
    const int aoff = lds_byte(wr * 64 + fr, fq * 8), boff = lds_byte(wc * 32 + fr, fq * 8);
#define PG8_SA(b, h) (((b) * 2 + (h)) * HTB)
#define PG8_SB(b, h) ((4 + (b) * 2 + (h)) * HTB)
#define PG8_STAGE(bufoff, gbase, voff) do { _Pragma("unroll") for (int _i = 0; _i < 2; ++_i) \
        __builtin_amdgcn_global_load_lds((const unsigned*)((const char*)(gbase) + (voff)[_i]), (PG8_LAS unsigned*)(lds + (bufoff) + ldsw + _i * 8192), 16, 0, 0); } while (0)
#define PG8_LDA(dst, b, h) do { _Pragma("unroll") for (int m = 0; m < 4; ++m) _Pragma("unroll") for (int k = 0; k < 2; ++k) dst[m][k] = *(const PG8_LAS bf16x8*)(lds + PG8_SA(b, h) + aoff + m * 2048 + k * 1024); } while (0)
#define PG8_LDB(dst, b, h) do { _Pragma("unroll") for (int n = 0; n < 2; ++n) _Pragma("unroll") for (int k = 0; k < 2; ++k) dst[n][k] = *(const PG8_LAS bf16x8*)(lds + PG8_SB(b, h) + boff + n * 2048 + k * 1024); } while (0)
#define PG8_MMA(ai, bj, At, Bt) do { __builtin_amdgcn_s_setprio(1); _Pragma("unroll") for (int m = 0; m < 4; ++m) _Pragma("unroll") for (int n = 0; n < 2; ++n) _Pragma("unroll") for (int k = 0; k < 2; ++k) \
        acc[ai][bj][m][n] = __builtin_amdgcn_mfma_f32_16x16x32_bf16(Bt[n][k], At[m][k], acc[ai][bj][m][n], 0, 0, 0); __builtin_amdgcn_s_setprio(0); } while (0)
#define PG8_WAIT_V(n) asm volatile("s_waitcnt vmcnt(" #n ")" ::: "memory")
#define PG8_WAIT_L(n) asm volatile("s_waitcnt lgkmcnt(" #n ")" ::: "memory")
#define PG8_BAR __builtin_amdgcn_s_barrier()
#define PG8_SCHED __builtin_amdgcn_sched_barrier(0)
    Unit cur, nxt; int ui = 0;
    if (!S.next(0, cur)) return;
    f32x4 acc[2][2][4][2];
#pragma unroll
    for (int a = 0; a < 2; ++a)
#pragma unroll
        for (int b = 0; b < 2; ++b)
#pragma unroll
            for (int m = 0; m < 4; ++m)
#pragma unroll
                for (int n = 0; n < 2; ++n) acc[a][b][m][n] = (f32x4){0.f, 0.f, 0.f, 0.f};
    bf16x8 At[4][2], B0[2][2], B1[2][2];
    const char* cA = (const char*)g.A + (size_t)cur.pm * tstep; const char* cB = (const char*)g.Bt + (size_t)cur.pn * tstep;
    S.a_ready(cur);
    PG8_STAGE(PG8_SB(0, 0), cB, voffB); PG8_STAGE(PG8_SA(0, 0), cA, voffA); PG8_STAGE(PG8_SB(0, 1), cB + hstep, voffB); PG8_STAGE(PG8_SA(0, 1), cA + hstep, voffA);
    if (wr == 1) PG8_BAR;
    PG8_WAIT_V(4); PG8_BAR;
    PG8_STAGE(PG8_SB(1, 0), cB + kstep, voffB); PG8_STAGE(PG8_SA(1, 0), cA + kstep, voffA); PG8_STAGE(PG8_SB(1, 1), cB + hstep + kstep, voffB);
    PG8_WAIT_V(6); PG8_BAR;
    for (;;) {
        const bool has_next = S.next(ui + 1, nxt);
        const char* nA = has_next ? (const char*)g.A + (size_t)nxt.pm * tstep : cA; const char* nB = has_next ? (const char*)g.Bt + (size_t)nxt.pn * tstep : cB;
        for (int t = 0; t < nt; t += 2) {
            const bool last = (t == nt - 2);
            const char* a1 = cA + (size_t)(t + 1) * kstep;
            const char* a2 = last ? nA : cA + (size_t)(t + 2) * kstep; const char* b2 = last ? nB : cB + (size_t)(t + 2) * kstep;
            const char* a3 = a2 + kstep; const char* b3 = b2 + kstep;
            if (last && has_next) S.a_ready(nxt);
            PG8_LDB(B0, 0, 0); PG8_SCHED; PG8_LDA(At, 0, 0); PG8_STAGE(PG8_SA(1, 1), a1 + hstep, voffA);
            PG8_WAIT_L(8); PG8_BAR; PG8_WAIT_L(0); PG8_MMA(0, 0, At, B0); PG8_BAR; PG8_SCHED;
            PG8_LDB(B1, 0, 1); PG8_STAGE(PG8_SB(0, 0), b2, voffB);
            PG8_BAR; PG8_WAIT_L(0); PG8_MMA(0, 1, At, B1); PG8_BAR;
            PG8_LDA(At, 0, 1); PG8_STAGE(PG8_SA(0, 0), a2, voffA);
            PG8_BAR; PG8_WAIT_L(0); PG8_MMA(1, 0, At, B0); PG8_BAR; PG8_SCHED;
            PG8_STAGE(PG8_SB(0, 1), b2 + hstep, voffB);
            PG8_WAIT_V(6); PG8_BAR; PG8_MMA(1, 1, At, B1); PG8_BAR;
            PG8_LDB(B0, 1, 0); PG8_SCHED; PG8_LDA(At, 1, 0); PG8_STAGE(PG8_SA(0, 1), a2 + hstep, voffA);
            PG8_WAIT_L(8); PG8_BAR; PG8_WAIT_L(0); PG8_MMA(0, 0, At, B0); PG8_BAR; PG8_SCHED;
            PG8_LDB(B1, 1, 1); PG8_STAGE(PG8_SB(1, 0), b3, voffB);
            PG8_BAR; PG8_WAIT_L(0); PG8_MMA(0, 1, At, B1); PG8_BAR;
            PG8_LDA(At, 1, 1); PG8_STAGE(PG8_SA(1, 0), a3, voffA);
            PG8_BAR; PG8_WAIT_L(0); PG8_MMA(1, 0, At, B0); PG8_BAR; PG8_SCHED;
            PG8_STAGE(PG8_SB(1, 1), b3 + hstep, voffB);
            PG8_WAIT_V(6); PG8_BAR; PG8_MMA(1, 1, At, B1); PG8_BAR;
        }
        if constexpr (!Epi::AFTER_DRAIN) { E(acc, cur, wr, wc, fr, fq); S.done(cur); }
        if (!has_next) break;
#pragma unroll
        for (int a = 0; a < 2; ++a)
#pragma unroll
            for (int b = 0; b < 2; ++b)
#pragma unroll
                for (int m = 0; m < 4; ++m)
#pragma unroll
                    for (int n = 0; n < 2; ++n) acc[a][b][m][n] = (f32x4){0.f, 0.f, 0.f, 0.f};
        cur = nxt; cA = nA; cB = nB; ++ui;
    }
    PG8_WAIT_V(0);
    if (wr == 0) PG8_BAR;
    PG8_BAR;
    if constexpr (Epi::AFTER_DRAIN) { E.fused(acc, cur, wr, wc, fr, fq, lds, wid, lane); S.done(cur); }
#undef PG8_SA
#undef PG8_SB
#undef PG8_STAGE
#undef PG8_LDA
#undef PG8_LDB
#undef PG8_MMA
#undef PG8_WAIT_V
#undef PG8_WAIT_L
#undef PG8_BAR
#undef PG8_SCHED
}
}


#define LAS __attribute__((address_space(3)))
typedef unsigned short bf16_t;
typedef short bf16x8 __attribute__((ext_vector_type(8)));
typedef float f32x4 __attribute__((ext_vector_type(4)));
typedef float f32x16 __attribute__((ext_vector_type(16)));
typedef float f32x2 __attribute__((ext_vector_type(2)));
typedef __bf16 bf16x2_t __attribute__((ext_vector_type(2)));
typedef unsigned u32x2 __attribute__((ext_vector_type(2)));
typedef unsigned u32x4 __attribute__((ext_vector_type(4)));
#define DI __device__ __forceinline__
#define MFMA32(a, b, c) __builtin_amdgcn_mfma_f32_32x32x16_bf16((a), (b), (c), 0, 0, 0)

DI unsigned pk2(float lo, float hi) { f32x2 v = {lo, hi}; bf16x2_t b = __builtin_convertvector(v, bf16x2_t); return __builtin_bit_cast(unsigned, b); }
DI unsigned short f2bf(float x) { return (unsigned short)(pk2(x, 0.f) & 0xffffu); }
DI float bf2f(unsigned short b) { return __uint_as_float(((unsigned)b) << 16); }
DI u32x2 pk4(f32x4 v) { u32x2 r; r[0] = pk2(v[0], v[1]); r[1] = pk2(v[2], v[3]); return r; }
DI f32x4 unpk4(u32x2 u) { f32x4 r; r[0] = __uint_as_float(u[0] << 16); r[1] = __uint_as_float(u[0] & 0xffff0000u); r[2] = __uint_as_float(u[1] << 16); r[3] = __uint_as_float(u[1] & 0xffff0000u); return r; }
DI int crow(int reg, int h) { return (reg & 3) + 8 * (reg >> 2) + 4 * h; }
DI float sigmoidf_(float x) { return 1.f / (1.f + __expf(-x)); }
DI float siluf_(float x) { return x / (1.f + __expf(-x)); }
DI float geluf_(float x) { return 0.5f * x * (1.f + erff(x * 0.70710678118654752f)); }
#define xor_sum_fq(v) xor_sum_fq_((v), (fq << 4) | fr)

constexpr int T = 16384, SEQ = 4096;
constexpr int INC = 2208, INP = 2304, DFF = 2816, NGU = 6656;
constexpr float LN_EPS = 1e-5f, RMS_EPS = 1e-6f, ALPHA = 1.4142135623730951f;
constexpr float QSCALE = 0.10206207261596575f * 1.4426950408889634f;
constexpr size_t MiB = 1u << 20;
constexpr size_t O_CNT = 0, O_CSIN = 64 * 1024, O_BWIN = 80 * 1024, O_CSGU = 128 * 1024, O_BWGU = 192 * 1024;
constexpr size_t O_TAB = 512 * 1024;
constexpr size_t O_STAT = 1 * MiB, STAT_BYTES = (size_t)T * 8 * 4;
constexpr size_t O_ROPE = 3 * MiB;
constexpr size_t O_WIN = 5 * MiB, O_WUQ = O_WIN + (size_t)INP * 1024 * 2, O_WUKV = O_WUQ + 768 * 384 * 2, O_WOUT = O_WUKV + 1024 * 256 * 2,
    O_WGU = O_WOUT + 1024 * 1024 * 2, O_WDN = O_WGU + (size_t)NGU * 1024 * 2, O_WPP = O_WDN + (size_t)1024 * DFF * 2, O_WS = O_WPP + 1024 * 256 * 2, O_WEND = O_WS + 4 * 128 * 128 * 2;
static_assert(O_WEND <= 32 * MiB, "weights");
constexpr size_t O_AB = 32 * MiB, O_PB = 64 * MiB, O_MIX = 72 * MiB;
constexpr size_t O_LF = 104 * MiB, O_QH = 120 * MiB, O_KH = 128 * MiB, O_VH = 136 * MiB, O_GS = 144 * MiB, O_GU = 152 * MiB, O_GV = 160 * MiB, O_CQ = 168 * MiB, O_CKV = 180 * MiB,
    O_CKR = 188 * MiB, O_QF = 190 * MiB, O_KF = 214 * MiB, O_VT = 238 * MiB;
constexpr size_t O_PLE = 104 * MiB, O_ACT = 136 * MiB;
constexpr size_t O_CKVT = 32 * MiB, O_SP = 48 * MiB, O_DEC = 56 * MiB, O_EREF = 56 * MiB + 512 * 1024;
constexpr size_t WS_NEED = 256 * MiB;
constexpr int LDS_BYTES = 147456;

#ifndef PHMASK
#define PHMASK 0xffff
#endif
#define PH(k) if ((PHMASK >> (k)) & 1)
struct Params { const float* in[25]; float* out; unsigned char* ws; };
enum { I_X = 0, I_P, I_POS, I_LNING, I_LNINB, I_WIN, I_LBL, I_HNG, I_SLNG, I_SLNB, I_SWS, I_SBS, I_QNG, I_WUQ, I_KVNG, I_WUKV, I_WOUT, I_LN1G, I_LN1B, I_WGU, I_WDN, I_PWG, I_PWP, I_LN2G, I_LN2B };

DI int bid_() { int b = blockIdx.x; asm volatile("" : "+s"(b)); return b; }
DI int nblk_() { int b = gridDim.x; asm volatile("" : "+s"(b)); return b; }
DI int tid_(int wv) { int l; asm volatile("v_mbcnt_lo_u32_b32 %0, -1, 0\n\tv_mbcnt_hi_u32_b32 %0, -1, %0" : "=v"(l)); return (wv << 6) | l; }
DI float shx(float v, int mask, int lane) { return __int_as_float(__builtin_amdgcn_ds_bpermute((lane ^ mask) << 2, __float_as_int(v))); }
#define IN_(w, k) (((const float* const*)((w) + O_TAB + (size_t)bid_() * 256))[k])
#define OUT_(w) ((float*)(((const float* const*)((w) + O_TAB + (size_t)bid_() * 256))[25]))
DI float xor_sum_fq_(float v, int lane) { v += shx(v, 16, lane); v += shx(v, 32, lane); return v; }
DI void ln_stats(const float* st, float& mean, float& rstd) {
  const float s = st[0], q = st[1]; mean = s * (1.f / 1024.f); const float var = q * (1.f / 1024.f) - mean * mean; rstd = rsqrtf(fmaxf(var, 0.f) + LN_EPS);
}

DI void conv64(const float* __restrict__ W, int ldw, int k0, int klen, int c0, int nvalid, const float* __restrict__ g, const float* __restrict__ bv,
               bf16_t* __restrict__ dst, int ldd, float* cs_out, float* bw_out, unsigned char* smem, int wv) {
  bf16_t* tile = (bf16_t*)smem;
  float* red = (float*)(smem + 16384);
  const int tid = tid_(wv), c = tid & 63, kq = tid >> 6;
  const bool valid = (c0 + c) < nvalid;
  float cs = 0.f, bw = 0.f;
  for (int kt = 0; kt < klen; kt += 64) {
#pragma unroll
    for (int i = 0; i < 8; ++i) {
      const int k = k0 + kt + kq * 8 + i;
      const float w = valid ? W[(size_t)k * ldw + c0 + c] : 0.f;
      const float v = g ? w * g[k] : w;
      const unsigned short b = f2bf(v);
      cs += bf2f(b);
      if (bv) bw += bv[k] * w;
      tile[c * 72 + kq * 8 + i] = b;
    }
    __syncthreads();
    { const int cc = tid >> 3, kk = tid & 7;
      const u32x4 v = *(const u32x4*)(tile + cc * 72 + kk * 8);
      *(u32x4*)(dst + (size_t)cc * ldd + k0 + kt + kk * 8) = v; }
    __syncthreads();
  }
  if (cs_out) {
    red[kq * 64 + c] = cs; red[512 + kq * 64 + c] = bw; __syncthreads();
    if (tid < 64) { float a = 0.f, b = 0.f;
#pragma unroll
      for (int q = 0; q < 8; ++q) { a += red[q * 64 + tid]; b += red[512 + q * 64 + tid]; }
      cs_out[tid] = a; bw_out[tid] = b; }
    __syncthreads();
  }
}

DI void phase0(const Params& P, int L, unsigned char* smem, int wv) {
  unsigned char* ws = P.ws; asm volatile("" : "+s"(ws));
  const int tid = tid_(wv), lane = tid & 63, wid = tid >> 6;
  const int nblk = nblk_();
  for (int it = bid_(); it < 256; it += nblk) {
    if (it < 36) {
      const float* g = L == 0 ? IN_(ws, I_LNING) : IN_(ws, I_LN2G) + (size_t)(L - 1) * 1024;
      const float* b = L == 0 ? IN_(ws, I_LNINB) : IN_(ws, I_LN2B) + (size_t)(L - 1) * 1024;
      conv64(IN_(ws, I_WIN) + (size_t)L * 1024 * INC, INC, 0, 1024, it * 64, INC, g, b, (bf16_t*)(ws + O_WIN) + (size_t)it * 64 * 1024, 1024,
             (float*)(ws + O_CSIN) + it * 64, (float*)(ws + O_BWIN) + it * 64, smem, wv);
    } else if (it < 48) {
      const int j = it - 36;
      conv64(IN_(ws, I_WUQ) + (size_t)L * 384 * 768, 768, 0, 384, j * 64, 768, IN_(ws, I_QNG) + L * 384, nullptr, (bf16_t*)(ws + O_WUQ) + (size_t)j * 64 * 384, 384, nullptr, nullptr, smem, wv);
    } else if (it < 64) {
      const int j = it - 48;
      conv64(IN_(ws, I_WUKV) + (size_t)L * 256 * 1024, 1024, 0, 256, j * 64, 1024, IN_(ws, I_KVNG) + L * 256, nullptr, (bf16_t*)(ws + O_WUKV) + (size_t)j * 64 * 256, 256, nullptr, nullptr, smem, wv);
    } else if (it < 80) {
      const int j = it - 64;
      conv64(IN_(ws, I_WOUT) + (size_t)L * 1024 * 1024, 1024, 0, 1024, j * 64, 1024, nullptr, nullptr, (bf16_t*)(ws + O_WOUT) + (size_t)j * 64 * 1024, 1024, nullptr, nullptr, smem, wv);
    } else if (it < 168) {
      const int c0 = (it - 80) * 64;
      int drow;
      if (c0 < DFF) drow = 256 * (c0 >> 7) + (c0 & 127); else { const int c1 = c0 - DFF; drow = 256 * (c1 >> 7) + 128 + (c1 & 127); }
      conv64(IN_(ws, I_WGU) + (size_t)L * 1024 * 2 * DFF, 2 * DFF, 0, 1024, c0, 2 * DFF, IN_(ws, I_LN1G) + L * 1024, IN_(ws, I_LN1B) + L * 1024, (bf16_t*)(ws + O_WGU) + (size_t)drow * 1024, 1024,
             (float*)(ws + O_CSGU) + drow, (float*)(ws + O_BWGU) + drow, smem, wv);
    } else if (it < 184) {
      const int j = it - 168; const int drow = 2 * DFF + j * 64;
      conv64(IN_(ws, I_PWG) + (size_t)L * 1024 * 1024, 1024, 0, 1024, j * 64, 1024, IN_(ws, I_LN1G) + L * 1024, IN_(ws, I_LN1B) + L * 1024, (bf16_t*)(ws + O_WGU) + (size_t)drow * 1024, 1024,
             (float*)(ws + O_CSGU) + drow, (float*)(ws + O_BWGU) + drow, smem, wv);
    } else if (it < 232) {
      const int idx = it - 184, j = idx / 3, kc = idx - 3 * j;
      conv64(IN_(ws, I_WDN) + (size_t)L * DFF * 1024, 1024, kc * 1024, kc < 2 ? 1024 : 768, j * 64, 1024, nullptr, nullptr, (bf16_t*)(ws + O_WDN) + (size_t)j * 64 * DFF, DFF, nullptr, nullptr, smem, wv);
    } else if (it < 248) {
      const int j = it - 232;
      conv64(IN_(ws, I_PWP) + (size_t)L * 256 * 1024, 1024, 0, 256, j * 64, 1024, nullptr, nullptr, (bf16_t*)(ws + O_WPP) + (size_t)j * 64 * 256, 256, nullptr, nullptr, smem, wv);
    } else {
      const int j = it - 248;
      const float* src = IN_(ws, I_SWS) + (size_t)L * 65536; bf16_t* dst = (bf16_t*)(ws + O_WS);
      for (int e = j * 8192 + tid; e < (j + 1) * 8192; e += 512) { const int s = e & 127, t = (e >> 7) & 127; dst[e] = (s <= t) ? f2bf(src[e]) : (unsigned short)0; }
    }
  }
  {
    const float* src = IN_(ws, I_P) + (size_t)L * T * 256; bf16_t* dst = (bf16_t*)(ws + O_PB);
    for (size_t i = (size_t)bid_() * 512 + tid; i < (size_t)T * 256 / 8; i += (size_t)nblk * 512) {
      const f32x4 a = *(const f32x4*)(src + i * 8), b = *(const f32x4*)(src + i * 8 + 4);
      u32x4 o; o[0] = pk2(a[0], a[1]); o[1] = pk2(a[2], a[3]); o[2] = pk2(b[0], b[1]); o[3] = pk2(b[2], b[3]);
      *(u32x4*)(dst + i * 8) = o;
    }
  }
  if (L == 0) {
    if (bid_() == 0 && tid < 16) ((int*)(ws + O_CNT))[tid] = 0;
    const float* x = IN_(ws, I_X); bf16_t* xb = (bf16_t*)(ws + O_AB); float* st = (float*)(ws + O_STAT);
    for (int row = bid_() * 8 + wid; row < T; row += nblk * 8) {
      float s = 0.f, q = 0.f;
#pragma unroll
      for (int j = 0; j < 4; ++j) {
        const f32x4 v = *(const f32x4*)(x + (size_t)row * 1024 + j * 256 + lane * 4);
        s += v[0] + v[1] + v[2] + v[3]; q += v[0] * v[0] + v[1] * v[1] + v[2] * v[2] + v[3] * v[3];
        *(u32x2*)(xb + (size_t)row * 1024 + j * 256 + lane * 4) = pk4(v);
      }
#pragma unroll
      for (int o = 32; o >= 1; o >>= 1) { s += shx(s, o, lane); q += shx(q, o, lane); }
      if (lane < 24) { float v = 0.f; if (lane == 0) v = s; if (lane == 1) v = q; st[(size_t)(lane >> 3) * T * 8 + (size_t)row * 8 + (lane & 7)] = v; }
    }
    const int* pos = (const int*)IN_(ws, I_POS); float* rope = (float*)(ws + O_ROPE);
    for (int i = bid_() * 512 + tid; i < T * 16; i += nblk * 512) {
      const int t = i >> 4, j = i & 15;
      const float inv = powf(10000.0f, -(float)j * (1.f / 16.f));
      const float ang = (float)pos[t] * inv;
      double rv = (double)ang * 0.15915494309189535; rv -= rint(rv);
      const float rr = (float)(rv * 6.283185307179586);
      rope[t * 32 + j] = cosf(rr); rope[t * 32 + 16 + j] = sinf(rr);
    }
  }
}
typedef f32x4 AccT[2][2][4][2];

struct EpiProj {
  static constexpr bool PERM = false, AFTER_DRAIN = false;
  const Params& P; unsigned char* ws; int layer;
  DI EpiProj(const Params& P_, unsigned char* w, int L) : P(P_), ws(w), layer(L) {}
  template <int ACT, int SM, int bj> DI void half_bf16(const AccT& acc, int pm, int wr, int wc, int fr, int fq, int cbase, size_t dsto, int ld, int coff, int slot) const {
    const int cb = cbase + wc * 32 + 4 * fq;
    bf16_t* dst = (bf16_t*)(ws + dsto); const float* cs = (const float*)(ws + O_CSIN); const float* bw = (const float*)(ws + O_BWIN);
    const float* stat_in = (const float*)(ws + O_STAT + (size_t)layer * STAT_BYTES); float* stat = (float*)(ws + O_STAT + (size_t)layer * STAT_BYTES);
    f32x4 csv[2], bwv[2];
#pragma unroll
    for (int n = 0; n < 2; ++n) { csv[n] = *(const f32x4*)(cs + cb + 16 * n); bwv[n] = *(const f32x4*)(bw + cb + 16 * n); }
#pragma unroll
    for (int ai = 0; ai < 2; ++ai)
#pragma unroll
      for (int m = 0; m < 4; ++m) {
        const int row = pm * 256 + ai * 128 + wr * 64 + m * 16 + fr;
        float mean, rstd; ln_stats(stat_in + (size_t)row * 8, mean, rstd);
        float s1 = 0.f, s2 = 0.f;
#pragma unroll
        for (int n = 0; n < 2; ++n) {
          f32x4 v = (acc[ai][bj][m][n] - csv[n] * mean) * rstd + bwv[n];
#pragma unroll
          for (int j = 0; j < 4; ++j) { if (ACT == 1) v[j] = siluf_(v[j]); if (ACT == 2) v[j] = geluf_(v[j]); }
          if (SM) { s1 += v[0] + v[1] + v[2] + v[3]; s2 += v[0] * v[0] + v[1] * v[1] + v[2] * v[2] + v[3] * v[3]; }
          *(u32x2*)(dst + (size_t)row * ld + (cb + 16 * n - coff)) = pk4(v);
        }
        if (SM) {
          s2 = xor_sum_fq(s2); if (SM == 2) s1 = xor_sum_fq(s1);
          if (fq == 0) { if (SM == 2) { atomicAdd(stat + (size_t)row * 8 + slot, s1); atomicAdd(stat + (size_t)row * 8 + slot + 1, s2); } else atomicAdd(stat + (size_t)row * 8 + slot, s2); }
        }
      }
  }
  template <int bj> DI void half_forget(const AccT& acc, int pm, int wr, int wc, int fr, int fq, int cbase) const {
    const int cb = cbase + wc * 32 + 4 * fq;
    const float* cs = (const float*)(ws + O_CSIN); const float* bw = (const float*)(ws + O_BWIN); const float* lbl = IN_(ws, I_LBL);
    const float* stat_in = (const float*)(ws + O_STAT + (size_t)layer * STAT_BYTES); float* LF = (float*)(ws + O_LF); bf16_t* KH = (bf16_t*)(ws + O_KH);
    f32x4 csv[2], bwv[2], lb[2];
#pragma unroll
    for (int n = 0; n < 2; ++n) {
      csv[n] = *(const f32x4*)(cs + cb + 16 * n); bwv[n] = *(const f32x4*)(bw + cb + 16 * n);
      const f32x4 l0 = *(const f32x4*)(lbl + (cb + 16 * n - 256)), l1 = *(const f32x4*)(lbl + 256 + (cb + 16 * n - 256));
#pragma unroll
      for (int j = 0; j < 4; ++j) lb[n][j] = layer == 0 ? 0.f : 1.f / (1.f + expf(l0[j] - l1[j]));
    }
#pragma unroll
    for (int ai = 0; ai < 2; ++ai)
#pragma unroll
      for (int m = 0; m < 4; ++m) {
        const int row = pm * 256 + ai * 128 + wr * 64 + m * 16 + fr;
        float mean, rstd; ln_stats(stat_in + (size_t)row * 8, mean, rstd);
#pragma unroll
        for (int n = 0; n < 2; ++n) {
          const f32x4 v = (acc[ai][bj][m][n] - csv[n] * mean) * rstd + bwv[n];
          f32x4 lf, kk;
#pragma unroll
          for (int j = 0; j < 4; ++j) { const float sg = 1.f / (1.f + expf(-v[j])); const float f = lb[n][j] + (1.f - lb[n][j]) * sg; lf[j] = logf(f); kk[j] = 1.f - f; }
          *(f32x4*)(LF + (size_t)row * 256 + (cb + 16 * n - 256)) = lf;
          *(u32x2*)(KH + (size_t)row * 256 + (cb + 16 * n - 256)) = pk4(kk);
        }
      }
  }
  template <int bj> DI void half_ckr(const AccT& acc, int pm, int wr, int wc, int fr, int fq, int cbase) const {
    if (wc != 0) return;
    const int cb = cbase + 4 * fq;
    const float* cs = (const float*)(ws + O_CSIN); const float* bw = (const float*)(ws + O_BWIN);
    const float* stat_in = (const float*)(ws + O_STAT + (size_t)layer * STAT_BYTES); const float* rope = (const float*)(ws + O_ROPE); bf16_t* KFp = (bf16_t*)(ws + O_KF);
    f32x4 csv[2], bwv[2];
#pragma unroll
    for (int n = 0; n < 2; ++n) { csv[n] = *(const f32x4*)(cs + cb + 16 * n); bwv[n] = *(const f32x4*)(bw + cb + 16 * n); }
#pragma unroll
    for (int ai = 0; ai < 2; ++ai)
#pragma unroll
      for (int m = 0; m < 4; ++m) {
        const int row = pm * 256 + ai * 128 + wr * 64 + m * 16 + fr;
        float mean, rstd; ln_stats(stat_in + (size_t)row * 8, mean, rstd);
        const f32x4 x1 = (acc[ai][bj][m][0] - csv[0] * mean) * rstd + bwv[0], x2 = (acc[ai][bj][m][1] - csv[1] * mean) * rstd + bwv[1];
        const f32x4 cs4 = *(const f32x4*)(rope + (size_t)row * 32 + 4 * fq), sn4 = *(const f32x4*)(rope + (size_t)row * 32 + 16 + 4 * fq);
        const u32x2 o1 = pk4(x1 * cs4 - x2 * sn4), o2 = pk4(x2 * cs4 + x1 * sn4);
        bf16_t* kd = KFp + ((size_t)((row >> 12) * 8) * 4096 + (row & 4095)) * 96 + 64 + 4 * fq;
#pragma unroll
        for (int hd = 0; hd < 8; ++hd) { *(u32x2*)(kd + (size_t)hd * 4096 * 96) = o1; *(u32x2*)(kd + (size_t)hd * 4096 * 96 + 16) = o2; }
        __builtin_amdgcn_sched_barrier(0);
      }
  }
  template <int bj> DI void do_half(const AccT& acc, const pg8::Unit& u, int wr, int wc, int fr, int fq) const {
    { const int l_ = tid_(wr * 4 + wc) & 63; fr = l_ & 15; fq = l_ >> 4; }
      const int gid = u.pn * 2 + bj, cbase = gid * 128;
      switch (gid) {
        case 0: case 1:   half_bf16<1, 0, bj>(acc, u.pm, wr, wc, fr, fq, cbase, O_QH, 256, 0, 0); break;
        case 2: case 3:   half_forget<bj>(acc, u.pm, wr, wc, fr, fq, cbase); break;
        case 4: case 5:   half_bf16<0, 0, bj>(acc, u.pm, wr, wc, fr, fq, cbase, O_VH, 256, 512, 0); break;
        case 6: case 7:   half_bf16<1, 0, bj>(acc, u.pm, wr, wc, fr, fq, cbase, O_GS, 256, 768, 0); break;
        case 8: case 9:   half_bf16<2, 0, bj>(acc, u.pm, wr, wc, fr, fq, cbase, O_GU, 256, 1024, 0); break;
        case 10: case 11: half_bf16<2, 2, bj>(acc, u.pm, wr, wc, fr, fq, cbase, O_GV, 256, 1280, 6); break;
        case 12: case 13: case 14: half_bf16<0, 1, bj>(acc, u.pm, wr, wc, fr, fq, cbase, O_CQ, 384, 1536, 4); break;
        case 15: case 16: half_bf16<0, 1, bj>(acc, u.pm, wr, wc, fr, fq, cbase, O_CKV, 256, 1920, 5); break;
        default:          half_ckr<bj>(acc, u.pm, wr, wc, fr, fq, cbase); break;
      }
  }
  DI void operator()(const AccT& acc, const pg8::Unit& u, int wr, int wc, int fr, int fq) const {
    { const int l_ = tid_(wr * 4 + wc) & 63; fr = l_ & 15; fq = l_ >> 4; }
    do_half<0>(acc, u, wr, wc, fr, fq); do_half<1>(acc, u, wr, wc, fr, fq);
  }
};

struct EpiQ {
  static constexpr bool PERM = false, AFTER_DRAIN = false;
  unsigned char* ws; int L;
  DI void operator()(const AccT& acc, const pg8::Unit& u, int wr, int wc, int fr, int fq) const {
    { const int l_ = tid_(wr * 4 + wc) & 63; fr = l_ & 15; fq = l_ >> 4; }
    const float* stat = (const float*)(ws + O_STAT + (size_t)L * STAT_BYTES); const float* rope = (const float*)(ws + O_ROPE);
    half<0>(acc, u, wr, wc, fr, fq); half<1>(acc, u, wr, wc, fr, fq);
  }
  template <int bj> DI void half(const AccT& acc, const pg8::Unit& u, int wr, int wc, int fr, int fq) const {
    { const int l_ = tid_(wr * 4 + wc) & 63; fr = l_ & 15; fq = l_ >> 4; }
    const float* stat = (const float*)(ws + O_STAT + (size_t)L * STAT_BYTES); const float* rope = (const float*)(ws + O_ROPE);
    const int b = u.pm >> 4, s0 = (u.pm & 15) * 256;
    {
      const int g32 = 8 * u.pn + 4 * bj + wc, head = g32 / 3, part = g32 - 3 * head;
      bf16_t* base = (bf16_t*)(ws + O_QF) + (size_t)((b * 8 + head) * 4096 + s0) * 96 + part * 32;
#pragma unroll
      for (int ai = 0; ai < 2; ++ai)
#pragma unroll
        for (int m = 0; m < 4; ++m) {
          const int rl = ai * 128 + wr * 64 + m * 16 + fr, row = u.pm * 256 + rl;
          const float rs = rsqrtf(stat[row * 8 + 4] * (1.f / 384.f) + RMS_EPS) * QSCALE;
          bf16_t* dst = base + rl * 96 + 4 * fq;
          const f32x4 x1 = acc[ai][bj][m][0] * rs, x2 = acc[ai][bj][m][1] * rs;
          if (part < 2) { *(u32x2*)dst = pk4(x1); *(u32x2*)(dst + 16) = pk4(x2); }
          else { const f32x4 cs4 = *(const f32x4*)(rope + row * 32 + 4 * fq), sn4 = *(const f32x4*)(rope + row * 32 + 16 + 4 * fq);
            *(u32x2*)dst = pk4(x1 * cs4 - x2 * sn4); *(u32x2*)(dst + 16) = pk4(x2 * cs4 + x1 * sn4); }
          __builtin_amdgcn_sched_barrier(0);
        }
    }
  }
};
struct EpiKV {
  static constexpr bool PERM = false, AFTER_DRAIN = false;
  unsigned char* ws; int L;
  DI void operator()(const AccT& acc, const pg8::Unit& u, int wr, int wc, int fr, int fq) const {
    { const int l_ = tid_(wr * 4 + wc) & 63; fr = l_ & 15; fq = l_ >> 4; }
    half<0>(acc, u, wr, wc, fr, fq); half<1>(acc, u, wr, wc, fr, fq);
  }
  template <int bj> DI void half(const AccT& acc, const pg8::Unit& u, int wr, int wc, int fr, int fq) const {
    const float* stat = (const float*)(ws + O_STAT + (size_t)L * STAT_BYTES);
    const int b = u.pm >> 4, s0 = (u.pm & 15) * 256, head = 2 * u.pn + bj;
    bf16_t* base = wc < 2 ? (bf16_t*)(ws + O_KF) + (size_t)((b * 8 + head) * 4096 + s0) * 96 + 32 * wc : (bf16_t*)(ws + O_VT) + (size_t)((b * 8 + head) * 4096 + s0) * 64 + 32 * (wc - 2);
    const int ld = wc < 2 ? 96 : 64;
#pragma unroll
    for (int ai = 0; ai < 2; ++ai)
#pragma unroll
      for (int m = 0; m < 4; ++m) {
        const int rl = ai * 128 + wr * 64 + m * 16 + fr, row = u.pm * 256 + rl;
        const float rs = rsqrtf(stat[row * 8 + 5] * (1.f / 256.f) + RMS_EPS);
        bf16_t* dst = base + rl * ld + 4 * fq;
        *(u32x2*)dst = pk4(acc[ai][bj][m][0] * rs); *(u32x2*)(dst + 16) = pk4(acc[ai][bj][m][1] * rs);
        __builtin_amdgcn_sched_barrier(0);
      }
  }
};
struct EpiOut {
  static constexpr bool PERM = false, AFTER_DRAIN = false;
  const Params& P; unsigned char* ws; int L;
  DI EpiOut(const Params& P_, unsigned char* w, int L_) : P(P_), ws(w), L(L_) {}
  DI void operator()(const AccT& acc, const pg8::Unit& u, int wr, int wc, int fr, int fq) const {
    { const int l_ = tid_(wr * 4 + wc) & 63; fr = l_ & 15; fq = l_ >> 4; }
    const float* src = L == 0 ? IN_(ws, I_X) : OUT_(ws); float* out = OUT_(ws); float* stat = (float*)(ws + O_STAT + (size_t)L * STAT_BYTES);
    const float* g = L == 0 ? IN_(ws, I_LNING) : IN_(ws, I_LN2G) + (size_t)(L - 1) * 1024; const float* b = L == 0 ? IN_(ws, I_LNINB) : IN_(ws, I_LN2B) + (size_t)(L - 1) * 1024; bf16_t* YB = (bf16_t*)(ws + O_AB);
    const int c0 = u.pn * 256 + wc * 32 + 4 * fq;
    f32x4 gv[2][2], bv[2][2];
#pragma unroll
    for (int bj = 0; bj < 2; ++bj)
#pragma unroll
      for (int n = 0; n < 2; ++n) { gv[bj][n] = *(const f32x4*)(g + c0 + 128 * bj + 16 * n); bv[bj][n] = *(const f32x4*)(b + c0 + 128 * bj + 16 * n); }
#pragma unroll
    for (int ai = 0; ai < 2; ++ai)
#pragma unroll
      for (int m = 0; m < 4; ++m) {
        const int row = u.pm * 256 + ai * 128 + wr * 64 + m * 16 + fr;
        float mean, rstd; ln_stats(stat + (size_t)row * 8, mean, rstd);
        float s1 = 0.f, s2 = 0.f;
#pragma unroll
        for (int bj = 0; bj < 2; ++bj)
#pragma unroll
          for (int n = 0; n < 2; ++n) {
            const size_t o = (size_t)row * 1024 + c0 + 128 * bj + 16 * n;
            const f32x4 x = *(const f32x4*)(src + o);
            const f32x4 y = ((x - mean) * rstd * gv[bj][n] + bv[bj][n]) * ALPHA + acc[ai][bj][m][n];
            *(f32x4*)(out + o) = y; *(u32x2*)(YB + o) = pk4(y);
            s1 += y[0] + y[1] + y[2] + y[3]; s2 += y[0] * y[0] + y[1] * y[1] + y[2] * y[2] + y[3] * y[3];
          }
        s1 = xor_sum_fq(s1); s2 = xor_sum_fq(s2);
        if (fq == 0) { atomicAdd(stat + (size_t)row * 8 + 2, s1); atomicAdd(stat + (size_t)row * 8 + 3, s2); }
      }
  }
};
struct EpiPle {
  static constexpr bool PERM = false, AFTER_DRAIN = false;
  unsigned char* ws;
  DI void operator()(const AccT& acc, const pg8::Unit& u, int wr, int wc, int fr, int fq) const {
    { const int l_ = tid_(wr * 4 + wc) & 63; fr = l_ & 15; fq = l_ >> 4; }
    const int c0 = u.pn * 256 + wc * 32 + 4 * fq; bf16_t* PLE = (bf16_t*)(ws + O_PLE);
#pragma unroll
    for (int ai = 0; ai < 2; ++ai)
#pragma unroll
      for (int m = 0; m < 4; ++m) {
        const int row = u.pm * 256 + ai * 128 + wr * 64 + m * 16 + fr;
#pragma unroll
        for (int bj = 0; bj < 2; ++bj)
#pragma unroll
          for (int n = 0; n < 2; ++n) *(u32x2*)(PLE + (size_t)row * 1024 + c0 + 128 * bj + 16 * n) = pk4(acc[ai][bj][m][n]);
      }
  }
};
struct EpiGU {
  static constexpr bool PERM = false, AFTER_DRAIN = false;
  unsigned char* ws; int L;
  DI void operator()(const AccT& acc, const pg8::Unit& u, int wr, int wc, int fr, int fq) const {
    { const int l_ = tid_(wr * 4 + wc) & 63; fr = l_ & 15; fq = l_ >> 4; }
    const float* stat = (const float*)(ws + O_STAT + (size_t)L * STAT_BYTES); const float* cs = (const float*)(ws + O_CSGU); const float* bw = (const float*)(ws + O_BWGU);
    bf16_t* ACT = (bf16_t*)(ws + O_ACT); bf16_t* PLE = (bf16_t*)(ws + O_PLE);
    const int c0 = u.pn * 256 + wc * 32 + 4 * fq;
    f32x4 csv[2][2], bwv[2][2];
#pragma unroll
    for (int bj = 0; bj < 2; ++bj)
#pragma unroll
      for (int n = 0; n < 2; ++n) { csv[bj][n] = *(const f32x4*)(cs + c0 + 128 * bj + 16 * n); bwv[bj][n] = *(const f32x4*)(bw + c0 + 128 * bj + 16 * n); }
#pragma unroll
    for (int ai = 0; ai < 2; ++ai)
#pragma unroll
      for (int m = 0; m < 4; ++m) {
        const int row = u.pm * 256 + ai * 128 + wr * 64 + m * 16 + fr;
        float mean, rstd; ln_stats(stat + (size_t)row * 8 + 2, mean, rstd);
        if (u.pn < 22) {
#pragma unroll
          for (int n = 0; n < 2; ++n) {
            const f32x4 gt = (acc[ai][0][m][n] - csv[0][n] * mean) * rstd + bwv[0][n];
            const f32x4 up = (acc[ai][1][m][n] - csv[1][n] * mean) * rstd + bwv[1][n];
            f32x4 a;
#pragma unroll
            for (int j = 0; j < 4; ++j) a[j] = siluf_(gt[j]) * up[j];
            *(u32x2*)(ACT + (size_t)row * DFF + u.pn * 128 + wc * 32 + 16 * n + 4 * fq) = pk4(a);
          }
        } else {
#pragma unroll
          for (int bj = 0; bj < 2; ++bj)
#pragma unroll
            for (int n = 0; n < 2; ++n) {
              const f32x4 v = (acc[ai][bj][m][n] - csv[bj][n] * mean) * rstd + bwv[bj][n];
              bf16_t* pp = PLE + (size_t)row * 1024 + (c0 - 2 * DFF) + 128 * bj + 16 * n;
              const f32x4 pl = unpk4(*(const u32x2*)pp);
              f32x4 o;
#pragma unroll
              for (int j = 0; j < 4; ++j) o[j] = sigmoidf_(v[j]) * pl[j];
              *(u32x2*)pp = pk4(o);
            }
        }
      }
  }
};
struct EpiDown {
  static constexpr bool PERM = false, AFTER_DRAIN = false;
  const Params& P; unsigned char* ws; int L;
  DI EpiDown(const Params& P_, unsigned char* w, int L_) : P(P_), ws(w), L(L_) {}
  DI void operator()(const AccT& acc, const pg8::Unit& u, int wr, int wc, int fr, int fq) const {
    { const int l_ = tid_(wr * 4 + wc) & 63; fr = l_ & 15; fq = l_ >> 4; }
    float* out = OUT_(ws); const float* stat = (const float*)(ws + O_STAT + (size_t)L * STAT_BYTES); float* stat_next = (float*)(ws + O_STAT + (size_t)(L + 1) * STAT_BYTES);
    const float* g = IN_(ws, I_LN1G) + (size_t)L * 1024; const float* b = IN_(ws, I_LN1B) + (size_t)L * 1024; const bf16_t* PLE = (const bf16_t*)(ws + O_PLE); bf16_t* ZB = (bf16_t*)(ws + O_AB);
    const int c0 = u.pn * 256 + wc * 32 + 4 * fq;
    f32x4 gv[2][2], bv[2][2];
#pragma unroll
    for (int bj = 0; bj < 2; ++bj)
#pragma unroll
      for (int n = 0; n < 2; ++n) { gv[bj][n] = *(const f32x4*)(g + c0 + 128 * bj + 16 * n); bv[bj][n] = *(const f32x4*)(b + c0 + 128 * bj + 16 * n); }
#pragma unroll
    for (int ai = 0; ai < 2; ++ai)
#pragma unroll
      for (int m = 0; m < 4; ++m) {
        const int row = u.pm * 256 + ai * 128 + wr * 64 + m * 16 + fr;
        float mean, rstd; ln_stats(stat + (size_t)row * 8 + 2, mean, rstd);
        float s1 = 0.f, s2 = 0.f;
#pragma unroll
        for (int bj = 0; bj < 2; ++bj)
#pragma unroll
          for (int n = 0; n < 2; ++n) {
            const size_t o = (size_t)row * 1024 + c0 + 128 * bj + 16 * n;
            const f32x4 y = *(const f32x4*)(out + o);
            const f32x4 pl = unpk4(*(const u32x2*)(PLE + o));
            const f32x4 z = ((y - mean) * rstd * gv[bj][n] + bv[bj][n]) * ALPHA + acc[ai][bj][m][n] + pl;
            *(f32x4*)(out + o) = z; *(u32x2*)(ZB + o) = pk4(z);
            s1 += z[0] + z[1] + z[2] + z[3]; s2 += z[0] * z[0] + z[1] * z[1] + z[2] * z[2] + z[3] * z[3];
          }
        s1 = xor_sum_fq(s1); s2 = xor_sum_fq(s2);
        if (fq == 0) { atomicAdd(stat_next + (size_t)row * 8 + 0, s1); atomicAdd(stat_next + (size_t)row * 8 + 1, s2); }
      }
  }
};

template <class Epi> DI void run_gemm(unsigned char* smem, const bf16_t* A, const bf16_t* Bt, int M, int N, int K, const Epi& E, int wv) {
  pg8::StaticOrder S; S.init(M, N, nblk_(), (int)bid_());
  pg8::Gemm g; g.A = A; g.Bt = Bt; g.M = M; g.N = N; g.K = K;
  __syncthreads();
  pg8::gemm_phase<Epi, pg8::StaticOrder>((LAS unsigned char*)smem, g, S, E, wv);
  __syncthreads();
}
DI void sgu_item(const Params& P, int L, int item, unsigned char* smem, int wv) {
  unsigned char* ws = P.ws; asm volatile("" : "+s"(ws));
  const int tid = tid_(wv), lane = tid & 63, wid = tid >> 6, r = lane & 31, hh = lane >> 5;
  const int tok0 = item * 128;
  const bf16_t* GV = (const bf16_t*)(ws + O_GV); const bf16_t* GU = (const bf16_t*)(ws + O_GU); bf16_t* MIX = (bf16_t*)(ws + O_MIX);
  const float* stat = (const float*)(ws + O_STAT + (size_t)L * STAT_BYTES);
  bf16_t* sVl = (bf16_t*)smem;
  float* sMR = (float*)(smem + 69632);
  __syncthreads();
  if (tid < 128) { const float s = stat[(size_t)(tok0 + tid) * 8 + 6], q = stat[(size_t)(tok0 + tid) * 8 + 7]; const float mean = s * (1.f / 256.f); const float var = q * (1.f / 256.f) - mean * mean;
    sMR[tid * 2] = mean; sMR[tid * 2 + 1] = rsqrtf(fmaxf(var, 0.f) + LN_EPS); }
  __syncthreads();
  { const int cc = tid & 255, half = tid >> 8;
    const float lg = IN_(ws, I_SLNG)[L * 256 + cc], lbv = IN_(ws, I_SLNB)[L * 256 + cc];
    for (int s = half * 64; s < half * 64 + 64; ++s) {
      const float gv = bf2f(GV[(size_t)(tok0 + s) * 256 + cc]);
      sVl[cc * 136 + s] = f2bf((gv - sMR[s * 2]) * sMR[s * 2 + 1] * lg + lbv);
    } }
  __syncthreads();
  const int grp = wid >> 1;
  const bf16_t* Wg = (const bf16_t*)(ws + O_WS) + (size_t)grp * 128 * 128;
  const float* bs = IN_(ws, I_SBS) + (size_t)L * 512 + grp * 128;
#pragma unroll 1
  for (int tb = 0; tb < 4; ++tb) {
    f32x16 c; for (int i = 0; i < 16; ++i) c[i] = 0.f;
    const int nks = 2 * (tb + 1);
#pragma unroll 1
    for (int ks = 0; ks < nks; ++ks) {
      const bf16x8 a = *(const bf16x8*)(Wg + (size_t)(32 * tb + r) * 128 + 16 * ks + 8 * hh);
      const bf16x8 b = *(const bf16x8*)(sVl + (32 * wid + r) * 136 + 16 * ks + 8 * hh);
      c = MFMA32(a, b, c);
    }
#pragma unroll
    for (int i = 0; i < 16; ++i) {
      const int t = 32 * tb + crow(i, hh);
      const float z = c[i] + bs[t];
      const float uu = bf2f(GU[(size_t)(tok0 + t) * 256 + 32 * wid + r]);
      MIX[(size_t)(tok0 + t) * 1024 + 256 + 32 * wid + r] = f2bf(uu * z);
    }
  }
  __syncthreads();
}

template <int STEP> DI void hgrn_item(const Params& P, int L, int item, unsigned char* smem, int wv) {
  unsigned char* ws = P.ws; asm volatile("" : "+s"(ws));
  const int tid = tid_(wv), lane = tid & 63, wid = tid >> 6, r = lane & 31, hh = lane >> 5;
  const int n = item & 63, bh = item >> 6, b = bh >> 2, h = bh & 3;
  const int tok0 = b * 4096 + n * 64, col0 = h * 64;
  const float* LF = (const float*)(ws + O_LF); const bf16_t* QH = (const bf16_t*)(ws + O_QH); const bf16_t* KH = (const bf16_t*)(ws + O_KH);
  const bf16_t* VH = (const bf16_t*)(ws + O_VH); const bf16_t* GS = (const bf16_t*)(ws + O_GS);
  float* sB = (float*)smem;
  float* sSeg = (float*)(smem + 16640);
  bf16_t* sA = (bf16_t*)(smem + 18944);
  bf16_t* sQ = (bf16_t*)(smem + 28160);
  bf16_t* sVt = (bf16_t*)(smem + 37376);
  bf16_t* sS = (bf16_t*)(smem + 46592);
  bf16_t* sP = (bf16_t*)(smem + 55808);
  const int k = tid & 63, seg = tid >> 6;
  __syncthreads();
  { float v[8]; float run = 0.f;
#pragma unroll
    for (int i = 0; i < 8; ++i) { run += LF[(size_t)(tok0 + seg * 8 + i) * 256 + col0 + k]; v[i] = run; }
    sSeg[seg * 64 + k] = run; __syncthreads();
    float pre = 0.f;
#pragma unroll
    for (int s = 0; s < 8; ++s) if (s < seg) pre += sSeg[s * 64 + k];
#pragma unroll
    for (int i = 0; i < 8; ++i) sB[(seg * 8 + i) * 65 + k] = v[i] + pre;
  }
  __syncthreads();
#pragma unroll
  for (int i = 0; i < 8; ++i) { const int s = seg * 8 + i; sVt[k * 72 + s] = VH[(size_t)(tok0 + s) * 256 + col0 + k]; }
  if (STEP == 1) {
    const float bl = sB[63 * 65 + k];
#pragma unroll
    for (int i = 0; i < 8; ++i) { const int s = seg * 8 + i; const float kk = bf2f(KH[(size_t)(tok0 + s) * 256 + col0 + k]); sA[k * 72 + s] = f2bf(kk * __expf(bl - sB[s * 65 + k])); }
    if (seg == 0) { ((float*)(ws + O_DEC))[(size_t)item * 64 + k] = __expf(bl); ((float*)(ws + O_EREF))[(size_t)item * 64 + k] = __expf(sB[31 * 65 + k]); }
    __syncthreads();
    if (wid < 4) {
      const int vb = wid >> 1, kb = wid & 1;
      f32x16 c; for (int i = 0; i < 16; ++i) c[i] = 0.f;
#pragma unroll
      for (int ks = 0; ks < 4; ++ks) {
        const bf16x8 a = *(const bf16x8*)(sVt + (32 * vb + r) * 72 + 16 * ks + 8 * hh);
        const bf16x8 bb = *(const bf16x8*)(sA + (32 * kb + r) * 72 + 16 * ks + 8 * hh);
        c = MFMA32(a, bb, c);
      }
      float* dst = (float*)(ws + O_CKVT) + (size_t)item * 4096;
#pragma unroll
      for (int i = 0; i < 16; ++i) dst[(32 * vb + crow(i, hh)) * 64 + 32 * kb + r] = c[i];
    }
  } else {
    const float br = sB[31 * 65 + k];
#pragma unroll
    for (int i = 0; i < 8; ++i) {
      const int t = seg * 8 + i; const float bt = sB[t * 65 + k];
      const float qq = bf2f(QH[(size_t)(tok0 + t) * 256 + col0 + k]), kk = bf2f(KH[(size_t)(tok0 + t) * 256 + col0 + k]);
      sQ[t * 72 + k] = f2bf(qq * __expf(bt - br));
      sA[t * 72 + k] = f2bf(kk * __expf(br - bt));
    }
    { const int v = tid >> 3, part = tid & 7;
      *(u32x4*)(sS + v * 72 + part * 8) = *(const u32x4*)((const bf16_t*)(ws + O_SP) + (size_t)item * 4096 + v * 64 + part * 8); }
    __syncthreads();
    if (wid < 4) {
      const int sb = wid >> 1, tb = wid & 1;
      f32x16 c; for (int i = 0; i < 16; ++i) c[i] = 0.f;
      if (!(sb == 1 && tb == 0)) {
#pragma unroll
        for (int ks = 0; ks < 4; ++ks) {
          const bf16x8 a = *(const bf16x8*)(sA + (32 * sb + r) * 72 + 16 * ks + 8 * hh);
          const bf16x8 bb = *(const bf16x8*)(sQ + (32 * tb + r) * 72 + 16 * ks + 8 * hh);
          c = MFMA32(a, bb, c);
        }
      }
      const int t = 32 * tb + r;
#pragma unroll
      for (int g = 0; g < 4; ++g) {
        f32x4 v;
#pragma unroll
        for (int j = 0; j < 4; ++j) { const int s = 32 * sb + 8 * g + 4 * hh + j; v[j] = (s <= t) ? c[4 * g + j] : 0.f; }
        *(u32x2*)(sP + t * 72 + 32 * sb + 8 * g + 4 * hh) = pk4(v);
      }
    }
    __syncthreads();
    if (wid < 2) {
      const int tb = wid, t = 32 * tb + r;
      f32x16 c0, c1; for (int i = 0; i < 16; ++i) { c0[i] = 0.f; c1[i] = 0.f; }
#pragma unroll
      for (int ks = 0; ks < 4; ++ks) {
        const bf16x8 bp = *(const bf16x8*)(sP + t * 72 + 16 * ks + 8 * hh);
        const bf16x8 bq = *(const bf16x8*)(sQ + t * 72 + 16 * ks + 8 * hh);
        c0 = MFMA32(*(const bf16x8*)(sVt + r * 72 + 16 * ks + 8 * hh), bp, c0);
        c1 = MFMA32(*(const bf16x8*)(sVt + (32 + r) * 72 + 16 * ks + 8 * hh), bp, c1);
        c0 = MFMA32(*(const bf16x8*)(sS + r * 72 + 16 * ks + 8 * hh), bq, c0);
        c1 = MFMA32(*(const bf16x8*)(sS + (32 + r) * 72 + 16 * ks + 8 * hh), bq, c1);
      }
      float ss = 0.f;
#pragma unroll
      for (int i = 0; i < 16; ++i) ss += c0[i] * c0[i] + c1[i] * c1[i];
      ss += shx(ss, 32, lane);
      const float rn = rsqrtf(ss * (1.f / 64.f) + RMS_EPS);
      const float* ng = IN_(ws, I_HNG) + L * 256 + col0;
      bf16_t* MIX = (bf16_t*)(ws + O_MIX);
#pragma unroll
      for (int vb = 0; vb < 2; ++vb)
#pragma unroll
        for (int g = 0; g < 4; ++g) {
          const int v0 = 32 * vb + 8 * g + 4 * hh;
          const f32x4 gs = unpk4(*(const u32x2*)(GS + (size_t)(tok0 + t) * 256 + col0 + v0));
          const f32x4 nv = *(const f32x4*)(ng + v0);
          f32x4 o;
#pragma unroll
          for (int j = 0; j < 4; ++j) o[j] = (vb == 0 ? c0[4 * g + j] : c1[4 * g + j]) * rn * nv[j] * gs[j];
          *(u32x2*)(MIX + (size_t)(tok0 + t) * 1024 + col0 + v0) = pk4(o);
        }
    }
  }
  __syncthreads();
}

DI void hgrn_scan(const Params& P, int bh, int wv) {
  unsigned char* ws = P.ws; asm volatile("" : "+s"(ws));
  const int tid = tid_(wv), k = tid & 63, vq = tid >> 6;
  const float* DEC = (const float*)(ws + O_DEC) + (size_t)bh * 64 * 64; const float* EREF = (const float*)(ws + O_EREF) + (size_t)bh * 64 * 64;
  const float* CKVT = (const float*)(ws + O_CKVT) + (size_t)bh * 64 * 4096; bf16_t* SP = (bf16_t*)(ws + O_SP) + (size_t)bh * 64 * 4096;
  float S[8];
#pragma unroll
  for (int i = 0; i < 8; ++i) S[i] = 0.f;
#pragma unroll 4
  for (int n = 0; n < 64; ++n) {
    const float dec = DEC[n * 64 + k], er = EREF[n * 64 + k];
    float kv[8];
#pragma unroll
    for (int i = 0; i < 8; ++i) kv[i] = CKVT[(size_t)n * 4096 + (vq * 8 + i) * 64 + k];
#pragma unroll
    for (int i = 0; i < 8; ++i) { SP[(size_t)n * 4096 + (vq * 8 + i) * 64 + k] = f2bf(er * S[i]); S[i] = dec * S[i] + kv[i]; }
  }
}

DI void attn_unit(const Params& P, int bh, int qb, unsigned char* smem, int wv) {
  unsigned char* ws = P.ws; asm volatile("" : "+s"(ws));
  const int tid = tid_(wv), lane = tid & 63, wid = tid >> 6, r = lane & 31, hh = lane >> 5;
  const int sq = 256 * qb + 32 * wid + r;
  const bf16_t* QF = (const bf16_t*)(ws + O_QF); const bf16_t* kbase = (const bf16_t*)(ws + O_KF) + (size_t)bh * 4096 * 96;
  const bf16_t* vbase = (const bf16_t*)(ws + O_VT) + (size_t)bh * 4096 * 64;
  bf16x8 qf[6];
  { const bf16_t* qp = QF + ((size_t)bh * 4096 + sq) * 96 + 8 * hh;
#pragma unroll
    for (int ds = 0; ds < 6; ++ds) qf[ds] = *(const bf16x8*)(qp + 16 * ds); }
  f32x16 o0, o1; for (int i = 0; i < 16; ++i) { o0[i] = 0.f; o1[i] = 0.f; }
  float mrun = -INFINITY, lrun = 0.f;
  const int nt = 4 * qb + 4, ktmax = 4 * qb + (wid >> 1);
  const int kr0 = tid / 12, kc0 = tid - 12 * kr0; const int p1 = tid + 512; const int kr1 = p1 / 12, kc1 = p1 - 12 * kr1;
  const int vr = tid >> 3, vc = tid & 7;
  u32x4 rk0, rk1 = {0u, 0u, 0u, 0u}, rv;
#define AT_GLOAD(kt) do { const bf16_t* kp = kbase + (size_t)(kt) * 64 * 96; rk0 = *(const u32x4*)(kp + kr0 * 96 + kc0 * 8); if (tid < 256) rk1 = *(const u32x4*)(kp + kr1 * 96 + kc1 * 8); \
    rv = *(const u32x4*)(vbase + (size_t)((kt) * 64 + vr) * 64 + vc * 8); } while (0)
#define AT_SWRITE(buf) do { unsigned char* kd = smem + (buf) * 13312; *(u32x4*)(kd + kr0 * 208 + kc0 * 16) = rk0; if (tid < 256) *(u32x4*)(kd + kr1 * 208 + kc1 * 16) = rk1; \
    { bf16_t* vd = (bf16_t*)(smem + 26624 + (buf) * 9216) + (vc * 8) * 72 + vr; \
      vd[0] = (bf16_t)(rv[0] & 0xffffu); vd[72] = (bf16_t)(rv[0] >> 16); vd[144] = (bf16_t)(rv[1] & 0xffffu); vd[216] = (bf16_t)(rv[1] >> 16); \
      vd[288] = (bf16_t)(rv[2] & 0xffffu); vd[360] = (bf16_t)(rv[2] >> 16); vd[432] = (bf16_t)(rv[3] & 0xffffu); vd[504] = (bf16_t)(rv[3] >> 16); } } while (0)
  __syncthreads();
  AT_GLOAD(0); AT_SWRITE(0); __syncthreads();
#pragma unroll 1
  for (int kt = 0; kt < nt; ++kt) {
    const int cur = kt & 1;
    if (kt + 1 < nt) AT_GLOAD(kt + 1);
    if (kt <= ktmax) {
      const unsigned char* Kb = smem + cur * 13312; const unsigned char* Vb = smem + 26624 + cur * 9216;
      f32x16 p0, p1v; for (int i = 0; i < 16; ++i) { p0[i] = 0.f; p1v[i] = 0.f; }
#pragma unroll
      for (int ds = 0; ds < 6; ++ds) {
        const bf16x8 a0 = *(const bf16x8*)(Kb + r * 208 + ds * 32 + hh * 16);
        const bf16x8 a1 = *(const bf16x8*)(Kb + (32 + r) * 208 + ds * 32 + hh * 16);
        p0 = MFMA32(a0, qf[ds], p0); p1v = MFMA32(a1, qf[ds], p1v);
      }
      if (kt == ktmax) {
#pragma unroll
        for (int i = 0; i < 16; ++i) { const int key = 64 * kt + crow(i, hh); if (key > sq) p0[i] = -INFINITY; if (key + 32 > sq) p1v[i] = -INFINITY; }
      }
      float mx = p0[0];
#pragma unroll
      for (int i = 1; i < 16; ++i) mx = fmaxf(mx, p0[i]);
#pragma unroll
      for (int i = 0; i < 16; ++i) mx = fmaxf(mx, p1v[i]);
      mx = fmaxf(mx, shx(mx, 32, lane));
      const float mn = fmaxf(mrun, mx);
      const float alpha = __builtin_amdgcn_exp2f(mrun - mn);
      mrun = mn;
      float ls = 0.f;
#pragma unroll
      for (int i = 0; i < 16; ++i) { p0[i] = __builtin_amdgcn_exp2f(p0[i] - mn); p1v[i] = __builtin_amdgcn_exp2f(p1v[i] - mn); ls += p0[i] + p1v[i]; }
      lrun = lrun * alpha + ls;
#pragma unroll
      for (int i = 0; i < 16; ++i) { o0[i] *= alpha; o1[i] *= alpha; }
#pragma unroll
      for (int blk = 0; blk < 2; ++blk)
#pragma unroll
        for (int s2 = 0; s2 < 2; ++s2) {
          u32x4 pw;
#pragma unroll
          for (int j = 0; j < 4; ++j) pw[j] = blk == 0 ? pk2(p0[8 * s2 + 2 * j], p0[8 * s2 + 2 * j + 1]) : pk2(p1v[8 * s2 + 2 * j], p1v[8 * s2 + 2 * j + 1]);
          const bf16x8 pb = __builtin_bit_cast(bf16x8, pw);
          const int keyoff = 32 * blk + 16 * s2 + 4 * hh;
          { const u32x2 lo = *(const u32x2*)(Vb + r * 144 + keyoff * 2), hi = *(const u32x2*)(Vb + r * 144 + keyoff * 2 + 16);
            u32x4 av = {lo[0], lo[1], hi[0], hi[1]}; o0 = MFMA32(__builtin_bit_cast(bf16x8, av), pb, o0); }
          { const u32x2 lo = *(const u32x2*)(Vb + (32 + r) * 144 + keyoff * 2), hi = *(const u32x2*)(Vb + (32 + r) * 144 + keyoff * 2 + 16);
            u32x4 av = {lo[0], lo[1], hi[0], hi[1]}; o1 = MFMA32(__builtin_bit_cast(bf16x8, av), pb, o1); }
        }
    }
    if (kt + 1 < nt) AT_SWRITE(cur ^ 1);
    __syncthreads();
  }
#undef AT_GLOAD
#undef AT_SWRITE
  lrun += shx(lrun, 32, lane);
  const float inv = 1.f / lrun;
  const int b = bh >> 3, h = bh & 7;
  bf16_t* op = (bf16_t*)(ws + O_MIX) + (size_t)(b * 4096 + sq) * 1024 + 512 + h * 64;
#pragma unroll
  for (int g = 0; g < 4; ++g) {
    f32x4 a, c;
#pragma unroll
    for (int j = 0; j < 4; ++j) { a[j] = o0[4 * g + j] * inv; c[j] = o1[4 * g + j] * inv; }
    *(u32x2*)(op + 8 * g + 4 * hh) = pk4(a); *(u32x2*)(op + 32 + 8 * g + 4 * hh) = pk4(c);
  }
}

__global__ void __launch_bounds__(512, 2) fwd_megakernel(Params P) {
  extern __shared__ __attribute__((aligned(16))) unsigned char smem[];
  cg::grid_group grid = cg::this_grid();
  unsigned char* ws = P.ws;
  const int wv = __builtin_amdgcn_readfirstlane((int)(threadIdx.x >> 6));
  { const int tid = tid_(wv); const float** tab = (const float**)(P.ws + O_TAB + (size_t)bid_() * 256);
    if (tid == 0) {
      tab[0] = P.in[0]; tab[1] = P.in[1]; tab[2] = P.in[2]; tab[3] = P.in[3]; tab[4] = P.in[4]; tab[5] = P.in[5]; tab[6] = P.in[6]; tab[7] = P.in[7]; tab[8] = P.in[8]; tab[9] = P.in[9]; tab[10] = P.in[10]; tab[11] = P.in[11]; tab[12] = P.in[12]; tab[13] = P.in[13]; tab[14] = P.in[14]; tab[15] = P.in[15]; tab[16] = P.in[16]; tab[17] = P.in[17]; tab[18] = P.in[18]; tab[19] = P.in[19]; tab[20] = P.in[20]; tab[21] = P.in[21]; tab[22] = P.in[22]; tab[23] = P.in[23]; tab[24] = P.in[24];
      tab[25] = P.out; }
    __threadfence(); __syncthreads(); }
#pragma unroll 1
  for (int L = 0; L < 2; ++L) {
    PH(0) phase0(P, L, smem, wv);
    grid.sync();
    PH(1) { unsigned char* w = ws; asm volatile("" : "+s"(w)); EpiProj E(P, w, L);
      run_gemm(smem, (const bf16_t*)(w + O_AB), (const bf16_t*)(w + O_WIN), T, INP, 1024, E, wv); }
    grid.sync();
    PH(2) { unsigned char* w = ws; asm volatile("" : "+s"(w)); EpiQ E; E.ws = w; E.L = L;
      run_gemm(smem, (const bf16_t*)(w + O_CQ), (const bf16_t*)(w + O_WUQ), T, 768, 384, E, wv); }
    PH(3) { unsigned char* w = ws; asm volatile("" : "+s"(w)); EpiKV E; E.ws = w; E.L = L;
      run_gemm(smem, (const bf16_t*)(w + O_CKV), (const bf16_t*)(w + O_WUKV), T, 1024, 256, E, wv); }
    PH(4) for (int it = bid_(); it < 128; it += nblk_()) sgu_item(P, L, it, smem, wv);
    PH(5) for (int it = bid_(); it < 1024; it += nblk_()) hgrn_item<1>(P, L, it, smem, wv);
    grid.sync();
    PH(6) { int* cnt = (int*)(ws + O_CNT) + L; int* slot = (int*)(smem + 65536); const int tid = tid_(wv);
      for (;;) {
        __syncthreads();
        if (tid == 0) *slot = atomicAdd(cnt, 1);
        __syncthreads();
        const int it = *slot;
        if (it >= 16 + 512) break;
        if (it < 16) hgrn_scan(P, it, wv);
        else { const int idx = it - 16; attn_unit(P, idx & 31, 15 - (idx >> 5), smem, wv); }
      } }
    grid.sync();
    PH(7) for (int it = bid_(); it < 1024; it += nblk_()) hgrn_item<3>(P, L, it, smem, wv);
    grid.sync();
    PH(8) { unsigned char* w = ws; asm volatile("" : "+s"(w)); EpiOut E(P, w, L);
      run_gemm(smem, (const bf16_t*)(w + O_MIX), (const bf16_t*)(w + O_WOUT), T, 1024, 1024, E, wv); }
    PH(9) { unsigned char* w = ws; asm volatile("" : "+s"(w)); EpiPle E; E.ws = w;
      run_gemm(smem, (const bf16_t*)(w + O_PB), (const bf16_t*)(w + O_WPP), T, 1024, 256, E, wv); }
    grid.sync();
    PH(10) { unsigned char* w = ws; asm volatile("" : "+s"(w)); EpiGU E; E.ws = w; E.L = L;
      run_gemm(smem, (const bf16_t*)(w + O_AB), (const bf16_t*)(w + O_WGU), T, NGU, 1024, E, wv); }
    grid.sync();
    PH(11) { unsigned char* w = ws; asm volatile("" : "+s"(w)); EpiDown E(P, w, L);
      run_gemm(smem, (const bf16_t*)(w + O_ACT), (const bf16_t*)(w + O_WDN), T, 1024, DFF, E, wv); }
    grid.sync();
  }
  { const float* st = (const float*)(ws + O_STAT + 2 * STAT_BYTES); const float* g = IN_(ws, I_LN2G) + 1024; const float* b = IN_(ws, I_LN2B) + 1024;
    const int tid = tid_(wv);
    for (int i = bid_() * 512 + tid; i < T * 256; i += nblk_() * 512) {
      const int row = i >> 8, c = (i & 255) * 4;
      float mean, rstd; ln_stats(st + (size_t)row * 8, mean, rstd);
      const f32x4 z = *(const f32x4*)(OUT_(ws) + (size_t)row * 1024 + c);
      *(f32x4*)(OUT_(ws) + (size_t)row * 1024 + c) = (z - mean) * rstd * *(const f32x4*)(g + c) + *(const f32x4*)(b + c);
    } }
}

extern "C" void kernel_launch(void* const* d_in, const int* in_sizes, int n_in, void* d_out, int out_size, void* d_ws, size_t ws_size, hipStream_t stream) {
  static int grid_blocks = 0;
  if (grid_blocks == 0) {
    if (n_in != 25 || ws_size < WS_NEED) { fprintf(stderr, "kernel_launch: unexpected n_in %d or ws_size %zu\n", n_in, ws_size); grid_blocks = -1; return; }
    int dev = 0, cus = 0, per_cu = 0;
    hipGetDevice(&dev);
    hipDeviceGetAttribute(&cus, hipDeviceAttributeMultiprocessorCount, dev);
    if (hipFuncSetAttribute((const void*)fwd_megakernel, hipFuncAttributeMaxDynamicSharedMemorySize, LDS_BYTES) != hipSuccess) { fprintf(stderr, "kernel_launch: hipFuncSetAttribute failed\n"); }
    if (hipOccupancyMaxActiveBlocksPerMultiprocessor(&per_cu, (const void*)fwd_megakernel, 512, LDS_BYTES) != hipSuccess || per_cu < 1) { fprintf(stderr, "kernel_launch: occupancy query says %d\n", per_cu); per_cu = 1; }
    (void)hipGetLastError();
    grid_blocks = cus * 1;
    if (grid_blocks > 256) grid_blocks = 256;
  }
  if (grid_blocks < 0) return;
  Params p{};
  for (int i = 0; i < 25; ++i) p.in[i] = (const float*)d_in[i];
  p.out = (float*)d_out; p.ws = (unsigned char*)d_ws;
  void* args[] = {&p};
  hipError_t e = hipLaunchCooperativeKernel((const void*)fwd_megakernel, dim3(grid_blocks), dim3(512), args, LDS_BYTES, stream);
  if (e != hipSuccess) fprintf(stderr, "cooperative launch failed: %s (grid %d)\n", hipGetErrorString(e), grid_blocks);
}
```

```cpp
#include <hip/hip_runtime.h>
#include <hip/hip_cooperative_groups.h>
#include <cstdio>
#include <cstdint>
namespace cg = cooperative_groups;
__device__ __forceinline__ int tid_(int wv);
namespace pg8 {
#define PG8_LAS __attribute__((address_space(3)))
typedef unsigned short bf16_t;
typedef short bf16x8 __attribute__((ext_vector_type(8)));
typedef float f32x4 __attribute__((ext_vector_type(4)));
typedef unsigned u32x4 __attribute__((ext_vector_type(4)));
constexpr int BM = 256, BK = 64, HALF = 128, HTB = HALF * BK * 2  , STAGE_BYTES = 8 * HTB, NXCD = 8, WGM = 8;

__host__ __device__ __forceinline__ int lds_byte(int r, int c) { const int st = (r >> 4) * 2 + (c >> 5), rr = r & 15, cc = c & 31, ob = rr * 64 + cc * 2; return st * 1024 + (ob ^ (((ob >> 9) & 1) << 5)); }
__host__ __device__ __forceinline__ void stage_rc(int b, int& R, int& C) { const int st = b / 1024, sb = b % 1024, swz = sb ^ (((sb >> 9) & 1) << 5); R = (st >> 1) * 16 + swz / 64; C = (st & 1) * 32 + (swz % 64) / 2; }
__host__ __device__ __forceinline__ int perm32(int rho) { const int n = rho >> 4, i = rho & 15; return 8 * (i >> 2) + 4 * n + (i & 3); }

struct Unit { int pm, pn; };
struct Gemm { const bf16_t* A; const bf16_t* Bt; int M, N, K; };

struct StaticOrder {
    int nM, nN, nwg, G, c;
    __host__ __device__ void init(int M, int N, int G_, int c_) { nM = M / BM; nN = N / BM; nwg = nM * nN; G = G_; c = c_; }
    __host__ __device__ bool next(int i, Unit& u) const {
        const long L = (long)i * G + c; if (L >= nwg) return false;
        int wgid = (int)L; { const int q = nwg / NXCD, r = nwg % NXCD, xcd = wgid % NXCD, off = wgid / NXCD; wgid = (xcd < r ? xcd * (q + 1) : r * (q + 1) + (xcd - r) * q) + off; }
        const int nig = WGM * nN, gid = wgid / nig, fm = gid * WGM, gsz = (nM - fm) < WGM ? (nM - fm) : WGM;
        u.pm = fm + ((wgid % nig) % gsz); u.pn = (wgid % nig) / gsz; return true;
    }
    __device__ __forceinline__ void a_ready(const Unit&) const {}
    __device__ __forceinline__ void done(const Unit&) const {}
};

template <class Epi, class Sched>
__device__ __forceinline__ void gemm_phase(PG8_LAS unsigned char* lds, const Gemm g, const Sched& S, const Epi& E, int wv) {
    const int tid = tid_(wv), wid = __builtin_amdgcn_readfirstlane(tid >> 6), lane = tid & 63, wr = wid >> 2, wc = wid & 3, fr = lane & 15, fq = lane >> 4;
    const int K = g.K, nt = K / BK;
    unsigned voffA[2], voffB[2];
#pragma unroll
    for (int i = 0; i < 2; ++i) { int R, C; stage_rc(tid * 16 + i * 8192, R, C); const int Rb = Epi::PERM ? ((R & ~31) + perm32(R & 31)) : R;
        voffA[i] = (unsigned)(R * K + C) * 2u; voffB[i] = (unsigned)(Rb * K + C) * 2u; }
    const size_t kstep = (size_t)(BK * 2);
    const size_t hstep = (size_t)HALF * K * 2;
    const size_t tstep = 2 * hstep;
    const unsigned ldsw = (unsigned)wid * 1024u;
    const int aoff = lds_byte(wr * 64 + fr, fq * 8), boff = lds_byte(wc * 32 + fr, fq * 8);
#define PG8_SA(b, h) (((b) * 2 + (h)) * HTB)
#define PG8_SB(b, h) ((4 + (b) * 2 + (h)) * HTB)
#define PG8_STAGE(bufoff, gbase, voff) do { _Pragma("unroll") for (int _i = 0; _i < 2; ++_i) \
        __builtin_amdgcn_global_load_lds((const unsigned*)((const char*)(gbase) + (voff)[_i]), (PG8_LAS unsigned*)(lds + (bufoff) + ldsw + _i * 8192), 16, 0, 0); } while (0)
#define PG8_LDA(dst, b, h) do { _Pragma("unroll") for (int m = 0; m < 4; ++m) _Pragma("unroll") for (int k = 0; k < 2; ++k) dst[m][k] = *(const PG8_LAS bf16x8*)(lds + PG8_SA(b, h) + aoff + m * 2048 + k * 1024); } while (0)
#define PG8_LDB(dst, b, h) do { _Pragma("unroll") for (int n = 0; n < 2; ++n) _Pragma("unroll") for (int k = 0; k < 2; ++k) dst[n][k] = *(const PG8_LAS bf16x8*)(lds + PG8_SB(b, h) + boff + n * 2048 + k * 1024); } while (0)
#define PG8_MMA(ai, bj, At, Bt) do { __builtin_amdgcn_s_setprio(1); _Pragma("unroll") for (int m = 0; m < 4; ++m) _Pragma("unroll") for (int n = 0; n < 2; ++n) _Pragma("unroll") for (int k = 0; k < 2; ++k) \
        acc[ai][bj][m][n] = __builtin_amdgcn_mfma_f32_16x16x32_bf16(Bt[n][k], At[m][k], acc[ai][bj][m][n], 0, 0, 0); __builtin_amdgcn_s_setprio(0); } while (0)
#define PG8_WAIT_V(n) asm volatile("s_waitcnt vmcnt(" #n ")" ::: "memory")
#define PG8_WAIT_L(n) asm volatile("s_waitcnt lgkmcnt(" #n ")" ::: "memory")
#define PG8_BAR __builtin_amdgcn_s_barrier()
#define PG8_SCHED __builtin_amdgcn_sched_barrier(0)
    Unit cur, nxt; int ui = 0;
    if (!S.next(0, cur)) return;
    f32x4 acc[2][2][4][2];
#pragma unroll
    for (int a = 0; a < 2; ++a)
#pragma unroll
        for (int b = 0; b < 2; ++b)
#pragma unroll
            for (int m = 0; m < 4; ++m)
#pragma unroll
                for (int n = 0; n < 2; ++n) acc[a][b][m][n] = (f32x4){0.f, 0.f, 0.f, 0.f};
    bf16x8 At[4][2], B0[2][2], B1[2][2];
    float pf[6] = {0.f, 0.f, 0.f, 0.f, 0.f, 0.f};
    const char* cA = (const char*)g.A + (size_t)cur.pm * tstep; const char* cB = (const char*)g.Bt + (size_t)cur.pn * tstep;
    S.a_ready(cur);
    PG8_STAGE(PG8_SB(0, 0), cB, voffB); PG8_STAGE(PG8_SA(0, 0), cA, voffA); PG8_STAGE(PG8_SB(0, 1), cB + hstep, voffB); PG8_STAGE(PG8_SA(0, 1), cA + hstep, voffA);
    if (wr == 1) PG8_BAR;
    PG8_WAIT_V(4); PG8_BAR;
    PG8_STAGE(PG8_SB(1, 0), cB + kstep, voffB); PG8_STAGE(PG8_SA(1, 0), cA + kstep, voffA); PG8_STAGE(PG8_SB(1, 1), cB + hstep + kstep, voffB);
    PG8_WAIT_V(6); PG8_BAR;
    for (;;) {
        const bool has_next = S.next(ui + 1, nxt);
        const char* nA = has_next ? (const char*)g.A + (size_t)nxt.pm * tstep : cA; const char* nB = has_next ? (const char*)g.Bt + (size_t)nxt.pn * tstep : cB;
        for (int t = 0; t < nt; t += 2) {
            const bool last = (t == nt - 2);
            const char* a1 = cA + (size_t)(t + 1) * kstep;
            const char* a2 = last ? nA : cA + (size_t)(t + 2) * kstep; const char* b2 = last ? nB : cB + (size_t)(t + 2) * kstep;
            const char* a3 = a2 + kstep; const char* b3 = b2 + kstep;
            if (last && has_next) S.a_ready(nxt);
            if (last) E.prefetch(cur, wr, wc, tid_(wv) & 63, pf);
            PG8_LDB(B0, 0, 0); PG8_SCHED; PG8_LDA(At, 0, 0); PG8_STAGE(PG8_SA(1, 1), a1 + hstep, voffA);
            PG8_WAIT_L(8); PG8_BAR; PG8_WAIT_L(0); PG8_MMA(0, 0, At, B0); PG8_BAR; PG8_SCHED;
            PG8_LDB(B1, 0, 1); PG8_STAGE(PG8_SB(0, 0), b2, voffB);
            PG8_BAR; PG8_WAIT_L(0); PG8_MMA(0, 1, At, B1); PG8_BAR;
            PG8_LDA(At, 0, 1); PG8_STAGE(PG8_SA(0, 0), a2, voffA);
            PG8_BAR; PG8_WAIT_L(0); PG8_MMA(1, 0, At, B0); PG8_BAR; PG8_SCHED;
            PG8_STAGE(PG8_SB(0, 1), b2 + hstep, voffB);
            PG8_WAIT_V(6); PG8_BAR; PG8_MMA(1, 1, At, B1); PG8_BAR;
            PG8_LDB(B0, 1, 0); PG8_SCHED; PG8_LDA(At, 1, 0); PG8_STAGE(PG8_SA(0, 1), a2 + hstep, voffA);
            PG8_WAIT_L(8); PG8_BAR; PG8_WAIT_L(0); PG8_MMA(0, 0, At, B0); PG8_BAR; PG8_SCHED;
            PG8_LDB(B1, 1, 1); PG8_STAGE(PG8_SB(1, 0), b3, voffB);
            PG8_BAR; PG8_WAIT_L(0); PG8_MMA(0, 1, At, B1); PG8_BAR;
            PG8_LDA(At, 1, 1); PG8_STAGE(PG8_SA(1, 0), a3, voffA);
            PG8_BAR; PG8_WAIT_L(0); PG8_MMA(1, 0, At, B0); PG8_BAR; PG8_SCHED;
            PG8_STAGE(PG8_SB(1, 1), b3 + hstep, voffB);
            PG8_WAIT_V(6); PG8_BAR; PG8_MMA(1, 1, At, B1); PG8_BAR;
        }
        if constexpr (!Epi::AFTER_DRAIN) { E(acc, cur, wr, wc, fr, fq, pf); S.done(cur); }
        if (!has_next) break;
#pragma unroll
        for (int a = 0; a < 2; ++a)
#pragma unroll
            for (int b = 0; b < 2; ++b)
#pragma unroll
                for (int m = 0; m < 4; ++m)
#pragma unroll
                    for (int n = 0; n < 2; ++n) acc[a][b][m][n] = (f32x4){0.f, 0.f, 0.f, 0.f};
        cur = nxt; cA = nA; cB = nB; ++ui;
    }
    PG8_WAIT_V(0);
    if (wr == 0) PG8_BAR;
    PG8_BAR;
    if constexpr (Epi::AFTER_DRAIN) { E.fused(acc, cur, wr, wc, fr, fq, lds, wid, lane); S.done(cur); }
#undef PG8_SA
#undef PG8_SB
#undef PG8_STAGE
#undef PG8_LDA
#undef PG8_LDB
#undef PG8_MMA
#undef PG8_WAIT_V
#undef PG8_WAIT_L
#undef PG8_BAR
#undef PG8_SCHED
}
}


#define LAS __attribute__((address_space(3)))
typedef unsigned short bf16_t;
typedef short bf16x8 __attribute__((ext_vector_type(8)));
typedef float f32x4 __attribute__((ext_vector_type(4)));
typedef float f32x16 __attribute__((ext_vector_type(16)));
typedef float f32x2 __attribute__((ext_vector_type(2)));
typedef __bf16 bf16x2_t __attribute__((ext_vector_type(2)));
typedef unsigned u32x2 __attribute__((ext_vector_type(2)));
typedef unsigned u32x4 __attribute__((ext_vector_type(4)));
#define DI __device__ __forceinline__
#define MFMA32(a, b, c) __builtin_amdgcn_mfma_f32_32x32x16_bf16((a), (b), (c), 0, 0, 0)

DI unsigned pk2(float lo, float hi) { f32x2 v = {lo, hi}; bf16x2_t b = __builtin_convertvector(v, bf16x2_t); return __builtin_bit_cast(unsigned, b); }
DI unsigned short f2bf(float x) { return (unsigned short)(pk2(x, 0.f) & 0xffffu); }
DI float bf2f(unsigned short b) { return __uint_as_float(((unsigned)b) << 16); }
DI u32x2 pk4(f32x4 v) { u32x2 r; r[0] = pk2(v[0], v[1]); r[1] = pk2(v[2], v[3]); return r; }
DI f32x4 unpk4(u32x2 u) { f32x4 r; r[0] = __uint_as_float(u[0] << 16); r[1] = __uint_as_float(u[0] & 0xffff0000u); r[2] = __uint_as_float(u[1] << 16); r[3] = __uint_as_float(u[1] & 0xffff0000u); return r; }
DI int crow(int reg, int h) { return (reg & 3) + 8 * (reg >> 2) + 4 * h; }
DI float sigmoidf_(float x) { return __builtin_amdgcn_rcpf(1.f + __builtin_amdgcn_exp2f(x * -1.4426950408889634f)); }
DI float siluf_(float x) { return x * __builtin_amdgcn_rcpf(1.f + __builtin_amdgcn_exp2f(x * -1.4426950408889634f)); }
DI float geluf_(float v) {
  const float av = fabsf(v), t = __builtin_amdgcn_rcpf(av * 0.2316418882f + 1.0f);
  float q = t * 0.5307027145f + (-0.7265760135f); q = q * t + 0.7107068705f; q = q * t + (-0.142248368f); q = q * t + 0.127414796f; q = q * t;
  const float e = __builtin_amdgcn_exp2f((v * v) * (-0.72134752044f));
  const float m = v * (q * e);
  return v < 0.f ? m : v - m;
}
#define xor_sum_fq(v) xor_sum_fq_((v), (fq << 4) | fr)

constexpr int T = 16384, SEQ = 4096;
constexpr int INC = 2208, INP = 2304, DFF = 2816, NGU = 6656;
constexpr float LN_EPS = 1e-5f, RMS_EPS = 1e-6f, ALPHA = 1.4142135623730951f;
constexpr float QSCALE = 0.10206207261596575f * 1.4426950408889634f;
constexpr size_t MiB = 1u << 20;
constexpr size_t O_CNT = 0, O_CSIN = 64 * 1024, O_BWIN = 80 * 1024, O_CSGU = 128 * 1024, O_BWGU = 192 * 1024;
constexpr size_t O_TAB = 512 * 1024;
constexpr size_t O_STAT = 1 * MiB, STAT_BYTES = (size_t)T * 8 * 4;
constexpr size_t O_ROPE = 3 * MiB;
constexpr size_t O_WIN = 5 * MiB, O_WUQ = O_WIN + (size_t)INP * 1024 * 2, O_WUKV = O_WUQ + 768 * 384 * 2, O_WOUT = O_WUKV + 1024 * 256 * 2,
    O_WGU = O_WOUT + 1024 * 1024 * 2, O_WDN = O_WGU + (size_t)NGU * 1024 * 2, O_WPP = O_WDN + (size_t)1024 * DFF * 2, O_WS = O_WPP + 1024 * 256 * 2, O_WEND = O_WS + 4 * 128 * 128 * 2;
static_assert(O_WEND <= 32 * MiB, "weights");
constexpr size_t O_AB = 32 * MiB, O_PB = 64 * MiB, O_MIX = 72 * MiB;
constexpr size_t O_LF = 104 * MiB, O_QH = 120 * MiB, O_KH = 128 * MiB, O_VH = 136 * MiB, O_GS = 144 * MiB, O_GU = 152 * MiB, O_GV = 160 * MiB, O_CQ = 168 * MiB, O_CKV = 180 * MiB,
    O_CKR = 188 * MiB, O_QF = 190 * MiB, O_KF = 214 * MiB, O_VT = 238 * MiB;
constexpr size_t O_PLE = 104 * MiB, O_ACT = 136 * MiB;
constexpr size_t O_CKVT = 32 * MiB, O_SP = 48 * MiB, O_DEC = 56 * MiB, O_EREF = 56 * MiB + 512 * 1024;
constexpr size_t WS_NEED = 256 * MiB;
constexpr int LDS_BYTES = 147456;

#ifndef REP_ATTN
#define REP_ATTN 1
#endif
#ifndef REP_SMALL
#define REP_SMALL 1
#endif
#ifndef REP_P0
#define REP_P0 1
#endif
#ifndef PHMASK
#define PHMASK 0xffff
#endif
#define PH(k) if ((PHMASK >> (k)) & 1)
struct Params { const float* in[25]; float* out; unsigned char* ws; };
enum { I_X = 0, I_P, I_POS, I_LNING, I_LNINB, I_WIN, I_LBL, I_HNG, I_SLNG, I_SLNB, I_SWS, I_SBS, I_QNG, I_WUQ, I_KVNG, I_WUKV, I_WOUT, I_LN1G, I_LN1B, I_WGU, I_WDN, I_PWG, I_PWP, I_LN2G, I_LN2B };

DI int bid_() { int b = blockIdx.x; asm volatile("" : "+s"(b)); return b; }
DI int nblk_() { int b = gridDim.x; asm volatile("" : "+s"(b)); return b; }
DI int tid_(int wv) { int l; asm volatile("v_mbcnt_lo_u32_b32 %0, -1, 0\n\tv_mbcnt_hi_u32_b32 %0, -1, %0" : "=v"(l)); return (wv << 6) | l; }
DI float shx(float v, int mask, int lane) { return __int_as_float(__builtin_amdgcn_ds_bpermute((lane ^ mask) << 2, __float_as_int(v))); }
#define GAS __attribute__((address_space(1)))
#define LAUNDER_G(p) do { GAS unsigned char* g_ = (GAS unsigned char*)(p); asm volatile("" : "+s"(g_)); (p) = (unsigned char*)g_; } while (0)
DI const float* in_ptr_(unsigned char* w, int k) { const float* p = ((const float* const*)(w + O_TAB + (size_t)bid_() * 256))[k];

#if defined(__HIP_DEVICE_COMPILE__)
  __builtin_assume(!__builtin_amdgcn_is_shared((const void*)p)); __builtin_assume(!__builtin_amdgcn_is_private((const void*)p));
#endif
  return p; }
#define IN_(w, k) in_ptr_((w), (k))
#define OUT_(w) ((float*)in_ptr_((w), 25))
DI float xor_sum_fq_(float v, int lane) { v += shx(v, 16, lane); v += shx(v, 32, lane); return v; }
DI void ln_stats(const float* st, float& mean, float& rstd) {
  const float s = st[0], q = st[1]; mean = s * (1.f / 1024.f); const float var = q * (1.f / 1024.f) - mean * mean; rstd = rsqrtf(fmaxf(var, 0.f) + LN_EPS);
}

DI void conv64(const float* __restrict__ W, int ldw, int k0, int klen, int c0, int nvalid, const float* __restrict__ g, const float* __restrict__ bv,
               bf16_t* __restrict__ dst, int ldd, float* cs_out, float* bw_out, unsigned char* smem, int wv) {
  bf16_t* tile = (bf16_t*)smem;
  float* red = (float*)(smem + 20480);
  const int tid = tid_(wv), c = tid & 63, kq = wv;
  const bool valid = (c0 + c) < nvalid;
  float cs = 0.f, bw = 0.f;
  float w[16], gg[16], bb[16];
#define CV_LOAD(kt_) do { _Pragma("unroll") for (int i = 0; i < 16; ++i) { const int kx = k0 + (kt_) + kq * 16 + i; \
    w[i] = valid ? __builtin_nontemporal_load((const GAS float*)W + (size_t)kx * ldw + c0 + c) : 0.f; gg[i] = g ? ((const GAS float*)g)[kx] : 1.f; bb[i] = bv ? ((const GAS float*)bv)[kx] : 0.f; } } while (0)
  CV_LOAD(0);
  for (int kt = 0; kt < klen; kt += 128) {
#pragma unroll
    for (int i = 0; i < 16; ++i) {
      const unsigned short b = f2bf(w[i] * gg[i]);
      cs += bf2f(b); bw += bb[i] * w[i];
      tile[c * 136 + kq * 16 + i] = b;
    }
    if (kt + 128 < klen) CV_LOAD(kt + 128);
    __syncthreads();
#pragma unroll
    for (int pp = 0; pp < 2; ++pp) { const int p = tid + 512 * pp, cc = p >> 4, kk = p & 15;
      const u32x4 v = *(const u32x4*)(tile + cc * 136 + kk * 8);
      *(u32x4*)(dst + (size_t)cc * ldd + k0 + kt + kk * 8) = v; }
    __syncthreads();
  }
#undef CV_LOAD
  if (cs_out) {
    red[kq * 64 + c] = cs; red[512 + kq * 64 + c] = bw; __syncthreads();
    if (tid < 64) { float a = 0.f, b = 0.f;
#pragma unroll
      for (int q = 0; q < 8; ++q) { a += red[q * 64 + tid]; b += red[512 + q * 64 + tid]; }
      cs_out[tid] = a; bw_out[tid] = b; }
    __syncthreads();
  }
}

DI void phase0(const Params& P, int L, unsigned char* smem, int wv) {
  unsigned char* ws = P.ws; LAUNDER_G(ws);
  const int tid = tid_(wv), lane = tid & 63, wid = wv;
  const int nblk = nblk_();
  for (int it = bid_(); it < 256; it += nblk) {
    if (it < 36) {
      const float* g = L == 0 ? IN_(ws, I_LNING) : IN_(ws, I_LN2G) + (size_t)(L - 1) * 1024;
      const float* b = L == 0 ? IN_(ws, I_LNINB) : IN_(ws, I_LN2B) + (size_t)(L - 1) * 1024;
      conv64(IN_(ws, I_WIN) + (size_t)L * 1024 * INC, INC, 0, 1024, it * 64, INC, g, b, (bf16_t*)(ws + O_WIN) + (size_t)it * 64 * 1024, 1024,
             (float*)(ws + O_CSIN) + it * 64, (float*)(ws + O_BWIN) + it * 64, smem, wv);
    } else if (it < 48) {
      const int j = it - 36;
      conv64(IN_(ws, I_WUQ) + (size_t)L * 384 * 768, 768, 0, 384, j * 64, 768, IN_(ws, I_QNG) + L * 384, nullptr, (bf16_t*)(ws + O_WUQ) + (size_t)j * 64 * 384, 384, nullptr, nullptr, smem, wv);
    } else if (it < 64) {
      const int j = it - 48;
      conv64(IN_(ws, I_WUKV) + (size_t)L * 256 * 1024, 1024, 0, 256, j * 64, 1024, IN_(ws, I_KVNG) + L * 256, nullptr, (bf16_t*)(ws + O_WUKV) + (size_t)j * 64 * 256, 256, nullptr, nullptr, smem, wv);
    } else if (it < 80) {
      const int j = it - 64;
      conv64(IN_(ws, I_WOUT) + (size_t)L * 1024 * 1024, 1024, 0, 1024, j * 64, 1024, nullptr, nullptr, (bf16_t*)(ws + O_WOUT) + (size_t)j * 64 * 1024, 1024, nullptr, nullptr, smem, wv);
    } else if (it < 168) {
      const int c0 = (it - 80) * 64;
      int drow;
      if (c0 < DFF) drow = 256 * (c0 >> 7) + (c0 & 127); else { const int c1 = c0 - DFF; drow = 256 * (c1 >> 7) + 128 + (c1 & 127); }
      conv64(IN_(ws, I_WGU) + (size_t)L * 1024 * 2 * DFF, 2 * DFF, 0, 1024, c0, 2 * DFF, IN_(ws, I_LN1G) + L * 1024, IN_(ws, I_LN1B) + L * 1024, (bf16_t*)(ws + O_WGU) + (size_t)drow * 1024, 1024,
             (float*)(ws + O_CSGU) + drow, (float*)(ws + O_BWGU) + drow, smem, wv);
    } else if (it < 184) {
      const int j = it - 168; const int drow = 2 * DFF + j * 64;
      conv64(IN_(ws, I_PWG) + (size_t)L * 1024 * 1024, 1024, 0, 1024, j * 64, 1024, IN_(ws, I_LN1G) + L * 1024, IN_(ws, I_LN1B) + L * 1024, (bf16_t*)(ws + O_WGU) + (size_t)drow * 1024, 1024,
             (float*)(ws + O_CSGU) + drow, (float*)(ws + O_BWGU) + drow, smem, wv);
    } else if (it < 232) {
      const int idx = it - 184, j = idx / 3, kc = idx - 3 * j;
      conv64(IN_(ws, I_WDN) + (size_t)L * DFF * 1024, 1024, kc * 1024, kc < 2 ? 1024 : 768, j * 64, 1024, nullptr, nullptr, (bf16_t*)(ws + O_WDN) + (size_t)j * 64 * DFF, DFF, nullptr, nullptr, smem, wv);
    } else if (it < 248) {
      const int j = it - 232;
      conv64(IN_(ws, I_PWP) + (size_t)L * 256 * 1024, 1024, 0, 256, j * 64, 1024, nullptr, nullptr, (bf16_t*)(ws + O_WPP) + (size_t)j * 64 * 256, 256, nullptr, nullptr, smem, wv);
    } else {
      const int j = it - 248;
      const float* src = IN_(ws, I_SWS) + (size_t)L * 65536; bf16_t* dst = (bf16_t*)(ws + O_WS);
      for (int e = j * 8192 + tid; e < (j + 1) * 8192; e += 512) { const int s = e & 127, t = (e >> 7) & 127; dst[e] = (s <= t) ? f2bf(((const GAS float*)src)[e]) : (unsigned short)0; }
    }
  }
  {
    const float* src = IN_(ws, I_P) + (size_t)L * T * 256; bf16_t* dst = (bf16_t*)(ws + O_PB);
    const size_t nth = (size_t)nblk * 512, ntot = (size_t)T * 256 / 8;
    for (size_t i0 = (size_t)bid_() * 512 + tid; i0 < ntot; i0 += nth * 4) {
      f32x4 va[4], vb[4];
#pragma unroll
      for (int k = 0; k < 4; ++k) { const size_t i = i0 + k * nth < ntot ? i0 + k * nth : i0;
        va[k] = __builtin_nontemporal_load((const GAS f32x4*)(src + i * 8)); vb[k] = __builtin_nontemporal_load((const GAS f32x4*)(src + i * 8 + 4)); }
#pragma unroll
      for (int k = 0; k < 4; ++k) { const size_t i = i0 + k * nth;
        if (i < ntot) { u32x4 o; o[0] = pk2(va[k][0], va[k][1]); o[1] = pk2(va[k][2], va[k][3]); o[2] = pk2(vb[k][0], vb[k][1]); o[3] = pk2(vb[k][2], vb[k][3]);
          *(u32x4*)(dst + i * 8) = o; } }
    }
  }
  if (L == 0) {
    if (bid_() == 0 && tid < 16) ((int*)(ws + O_CNT))[tid] = 0;
    const float* x = IN_(ws, I_X); bf16_t* xb = (bf16_t*)(ws + O_AB); float* st = (float*)(ws + O_STAT);
    for (int row = bid_() * 8 + wid; row < T; row += nblk * 8) {
      float s = 0.f, q = 0.f;
#pragma unroll
      for (int j = 0; j < 4; ++j) {
        const f32x4 v = __builtin_nontemporal_load((const GAS f32x4*)(x + (size_t)row * 1024 + j * 256 + lane * 4));
        s += v[0] + v[1] + v[2] + v[3]; q += v[0] * v[0] + v[1] * v[1] + v[2] * v[2] + v[3] * v[3];
        *(u32x2*)(xb + (size_t)row * 1024 + j * 256 + lane * 4) = pk4(v);
      }
#pragma unroll
      for (int o = 32; o >= 1; o >>= 1) { s += shx(s, o, lane); q += shx(q, o, lane); }
      if (lane < 24) { float v = 0.f; if (lane == 0) v = s; if (lane == 1) v = q; st[(size_t)(lane >> 3) * T * 8 + (size_t)row * 8 + (lane & 7)] = v; }
    }
    const int* pos = (const int*)IN_(ws, I_POS); float* rope = (float*)(ws + O_ROPE);
    for (int i = bid_() * 512 + tid; i < T * 16; i += nblk * 512) {
      const int t = i >> 4, j = i & 15;
      const float inv = powf(10000.0f, -(float)j * (1.f / 16.f));
      const float ang = (float)((const GAS int*)pos)[t] * inv;
      double rv = (double)ang * 0.15915494309189535; rv -= rint(rv);
      const float rr = (float)(rv * 6.283185307179586);
      rope[t * 32 + j] = cosf(rr); rope[t * 32 + 16 + j] = sinf(rr);
    }
  }
}
typedef f32x4 AccT[2][2][4][2];
#define ROWSTATS(statp, off, base_row) float mean_[8], rstd_[8]; _Pragma("unroll") for (int q_ = 0; q_ < 8; ++q_) { const int row_ = (base_row) + (q_ >> 2) * 128 + (q_ & 3) * 16; \
    ln_stats((statp) + (size_t)row_ * 8 + (off), mean_[q_], rstd_[q_]); }


constexpr int LDS_EPI = 131072;
typedef float PfT[6];
DI void epi_prefetch(const float* stat, int off, const float* colA, const float* colB, const pg8::Unit& u, int wr, int wc, int lane, PfT& pf) {
  const int ra = u.pm * 256 + wr * 64 + ((lane >> 4) & 3) * 16 + (lane & 15);
  const f32x2 a = *(const GAS f32x2*)(stat + (size_t)ra * 8 + off), b = *(const GAS f32x2*)(stat + (size_t)(ra + 128) * 8 + off);
  const int col = u.pn * 256 + (lane >> 5) * 128 + wc * 32 + (lane & 31);
  pf[0] = a[0]; pf[1] = a[1]; pf[2] = b[0]; pf[3] = b[1]; pf[4] = ((const GAS float*)colA)[col]; pf[5] = ((const GAS float*)colB)[col];
}
#define EPI_STAGE(smem_, pf_, wid_, lane_) unsigned char* lw_ = (smem_) + LDS_EPI + (wid_) * 1536; { \
    const float m0_ = (pf_)[0] * (1.f / 1024.f), m1_ = (pf_)[2] * (1.f / 1024.f); \
    f32x2 w0_, w1_; w0_[0] = m0_; w0_[1] = rsqrtf(fmaxf((pf_)[1] * (1.f / 1024.f) - m0_ * m0_, 0.f) + LN_EPS); w1_[0] = m1_; w1_[1] = rsqrtf(fmaxf((pf_)[3] * (1.f / 1024.f) - m1_ * m1_, 0.f) + LN_EPS); \
    *(f32x2*)(lw_ + (lane_) * 8) = w0_; *(f32x2*)(lw_ + ((lane_) + 64) * 8) = w1_; *(float*)(lw_ + 1024 + (lane_) * 4) = (pf_)[4]; *(float*)(lw_ + 1280 + (lane_) * 4) = (pf_)[5]; } \
  float mean_[8], rstd_[8]; _Pragma("unroll") for (int q_ = 0; q_ < 8; ++q_) { const f32x2 t_ = *(const f32x2*)(lw_ + ((q_ >> 2) * 64 + (q_ & 3) * 16 + fr) * 8); mean_[q_] = t_[0]; rstd_[q_] = t_[1]; }
#define EPI_COLA(bj_, n_) (*(const f32x4*)(lw_ + 1024 + ((bj_) * 32 + 16 * (n_) + 4 * fq) * 4))
#define EPI_COLB(bj_, n_) (*(const f32x4*)(lw_ + 1280 + ((bj_) * 32 + 16 * (n_) + 4 * fq) * 4))
#define EPI_COLA_P(bj_, n_) (*(const f32x4*)(lw_ + 1024 + ((bj_) * 32 + 8 * fq + 4 * (n_)) * 4))
#define EPI_COLB_P(bj_, n_) (*(const f32x4*)(lw_ + 1280 + ((bj_) * 32 + 8 * fq + 4 * (n_)) * 4))
template <bool ATOM> struct EpiProj_ {
  static constexpr bool PERM = true, AFTER_DRAIN = false;
  const Params& P; unsigned char* ws; int layer; unsigned char* smem;
  DI EpiProj_(const Params& P_, unsigned char* w, int L, unsigned char* sm) : P(P_), ws(w), layer(L), smem(sm) {}
  template <int ACT, int SM, int bj> DI void half_bf16(const AccT& acc, int pm, int wr, int wc, int fr, int fq, int cbase, size_t dsto, int ld, int coff, int slot, const float (&mean_)[8], const float (&rstd_)[8], unsigned char* lw_) const {
    const int cb = cbase + wc * 32 + 8 * fq;
    bf16_t* dst = (bf16_t*)(ws + dsto); float* stat = (float*)(ws + O_STAT + (size_t)layer * STAT_BYTES);
    f32x4 csv[2], bwv[2];
#pragma unroll
    for (int n = 0; n < 2; ++n) { csv[n] = EPI_COLA_P(bj, n); bwv[n] = EPI_COLB_P(bj, n); }
#pragma unroll
    for (int ai = 0; ai < 2; ++ai)
#pragma unroll
      for (int m = 0; m < 4; ++m) {
        const int row = pm * 256 + ai * 128 + wr * 64 + m * 16 + fr;
        const float mean = mean_[ai * 4 + m], rstd = rstd_[ai * 4 + m];
        float s1 = 0.f, s2 = 0.f;
        u32x4 w_;
#pragma unroll
        for (int n = 0; n < 2; ++n) {
          f32x4 v = (acc[ai][bj][m][n] - csv[n] * mean) * rstd + bwv[n];
#pragma unroll
          for (int j = 0; j < 4; ++j) { if (ACT == 1) v[j] = siluf_(v[j]); if (ACT == 2) v[j] = geluf_(v[j]); }
          if (SM) { s1 += v[0] + v[1] + v[2] + v[3]; s2 += v[0] * v[0] + v[1] * v[1] + v[2] * v[2] + v[3] * v[3]; }
          const u32x2 h_ = pk4(v); w_[2 * n] = h_[0]; w_[2 * n + 1] = h_[1];
        }
        *(u32x4*)(dst + (size_t)row * ld + (cb - coff)) = w_;
        if (SM) {
          s2 = xor_sum_fq(s2); if (SM == 2) s1 = xor_sum_fq(s1);
          if (ATOM && fq == 0) { if (SM == 2) { atomicAdd(stat + (size_t)row * 8 + slot, s1); atomicAdd(stat + (size_t)row * 8 + slot + 1, s2); } else atomicAdd(stat + (size_t)row * 8 + slot, s2); }
        }
      }
  }
  template <int bj> DI void half_forget(const AccT& acc, int pm, int wr, int wc, int fr, int fq, int cbase, const float (&mean_)[8], const float (&rstd_)[8], unsigned char* lw_) const {
    const int cb = cbase + wc * 32 + 8 * fq;
    const float* lbl = IN_(ws, I_LBL); float* LF = (float*)(ws + O_LF); bf16_t* KH = (bf16_t*)(ws + O_KH);
    f32x4 csv[2], bwv[2], lb[2];
#pragma unroll
    for (int n = 0; n < 2; ++n) {
      csv[n] = EPI_COLA_P(bj, n); bwv[n] = EPI_COLB_P(bj, n);
      const f32x4 l0 = *(const f32x4*)(lbl + (cb + 4 * n - 256)), l1 = *(const f32x4*)(lbl + 256 + (cb + 4 * n - 256));
#pragma unroll
      for (int j = 0; j < 4; ++j) lb[n][j] = layer == 0 ? 0.f : 1.f / (1.f + expf(l0[j] - l1[j]));
    }
#pragma unroll
    for (int ai = 0; ai < 2; ++ai)
#pragma unroll
      for (int m = 0; m < 4; ++m) {
        const int row = pm * 256 + ai * 128 + wr * 64 + m * 16 + fr;
        const float mean = mean_[ai * 4 + m], rstd = rstd_[ai * 4 + m];
        u32x4 w_;
#pragma unroll
        for (int n = 0; n < 2; ++n) {
          const f32x4 v = (acc[ai][bj][m][n] - csv[n] * mean) * rstd + bwv[n];
          f32x4 lf, kk;
#pragma unroll
          for (int j = 0; j < 4; ++j) { const float sg = sigmoidf_(v[j]); const float f = lb[n][j] + (1.f - lb[n][j]) * sg; lf[j] = __logf(f); kk[j] = 1.f - f; }
          *(f32x4*)(LF + (size_t)row * 256 + (cb + 4 * n - 256)) = lf;
          const u32x2 h_ = pk4(kk); w_[2 * n] = h_[0]; w_[2 * n + 1] = h_[1];
        }
        *(u32x4*)(KH + (size_t)row * 256 + (cb - 256)) = w_;
      }
  }
  template <int bj> DI void half_ckr(const AccT& acc, int pm, int wr, int wc, int fr, int fq, int cbase, const float (&mean_)[8], const float (&rstd_)[8], unsigned char* lw_) const {
    if (wc != 0) return;
    const float* rope = (const float*)(ws + O_ROPE); bf16_t* KFp = (bf16_t*)(ws + O_KF);
    const int lane = (fq << 4) | fr;
    const bool isx1 = fq < 2;
    const int ri = 8 * (fq & 1);
    f32x4 csv[2], bwv[2];
#pragma unroll
    for (int n = 0; n < 2; ++n) { csv[n] = EPI_COLA_P(bj, n); bwv[n] = EPI_COLB_P(bj, n); }
    const int row0 = pm * 256 + wr * 64 + fr;
    f32x4 cc[2], sc[2], cn[2], sn[2];
#pragma unroll
    for (int n = 0; n < 2; ++n) { cc[n] = *(const f32x4*)(rope + (size_t)row0 * 32 + ri + 4 * n); sc[n] = *(const f32x4*)(rope + (size_t)row0 * 32 + 16 + ri + 4 * n); cn[n] = cc[n]; sn[n] = sc[n]; }
#pragma unroll
    for (int q = 0; q < 8; ++q) {
      const int ai = q >> 2, m = q & 3, row = row0 + ai * 128 + m * 16;
      if (q < 7) { const int rown = row0 + ((q + 1) >> 2) * 128 + ((q + 1) & 3) * 16;
#pragma unroll
        for (int n = 0; n < 2; ++n) { cn[n] = *(const f32x4*)(rope + (size_t)rown * 32 + ri + 4 * n); sn[n] = *(const f32x4*)(rope + (size_t)rown * 32 + 16 + ri + 4 * n); } }
      const float mean = mean_[q], rstd = rstd_[q];
      u32x4 w_;
#pragma unroll
      for (int n = 0; n < 2; ++n) {
        const f32x4 own = (acc[ai][bj][m][n] - csv[n] * mean) * rstd + bwv[n];
        f32x4 oth;
#pragma unroll
        for (int j = 0; j < 4; ++j) oth[j] = shx(own[j], 32, lane);
        const f32x4 res = isx1 ? own * cc[n] - oth * sc[n] : own * cc[n] + oth * sc[n];
        const u32x2 h_ = pk4(res); w_[2 * n] = h_[0]; w_[2 * n + 1] = h_[1];
      }
      bf16_t* kd = KFp + ((size_t)((row >> 12) * 8) * 4096 + (row & 4095)) * 96 + 64 + 8 * fq;
#pragma unroll
      for (int hd = 0; hd < 8; ++hd) *(u32x4*)(kd + (size_t)hd * 4096 * 96) = w_;
#pragma unroll
      for (int n = 0; n < 2; ++n) { cc[n] = cn[n]; sc[n] = sn[n]; }
    }
  }
  template <int bj> DI void do_half(const AccT& acc, const pg8::Unit& u, int wr, int wc, int fr, int fq, const float (&mean_)[8], const float (&rstd_)[8], unsigned char* lw_) const {
          const int gid = u.pn * 2 + bj, cbase = gid * 128;
      switch (gid) {
        case 0: case 1:   half_bf16<1, 0, bj>(acc, u.pm, wr, wc, fr, fq, cbase, O_QH, 256, 0, 0, mean_, rstd_, lw_); break;
        case 2: case 3:   half_forget<bj>(acc, u.pm, wr, wc, fr, fq, cbase, mean_, rstd_, lw_); break;
        case 4: case 5:   half_bf16<0, 0, bj>(acc, u.pm, wr, wc, fr, fq, cbase, O_VH, 256, 512, 0, mean_, rstd_, lw_); break;
        case 6: case 7:   half_bf16<1, 0, bj>(acc, u.pm, wr, wc, fr, fq, cbase, O_GS, 256, 768, 0, mean_, rstd_, lw_); break;
        case 8: case 9:   half_bf16<2, 0, bj>(acc, u.pm, wr, wc, fr, fq, cbase, O_GU, 256, 1024, 0, mean_, rstd_, lw_); break;
        case 10: case 11: half_bf16<2, 2, bj>(acc, u.pm, wr, wc, fr, fq, cbase, O_GV, 256, 1280, 6, mean_, rstd_, lw_); break;
        case 12: case 13: case 14: half_bf16<0, 1, bj>(acc, u.pm, wr, wc, fr, fq, cbase, O_CQ, 384, 1536, 4, mean_, rstd_, lw_); break;
        case 15: case 16: half_bf16<0, 1, bj>(acc, u.pm, wr, wc, fr, fq, cbase, O_CKV, 256, 1920, 5, mean_, rstd_, lw_); break;
        default:          half_ckr<bj>(acc, u.pm, wr, wc, fr, fq, cbase, mean_, rstd_, lw_); break;
      }
  }
  DI void prefetch(const pg8::Unit& u, int wr, int wc, int lane, PfT& pf) const {
    epi_prefetch((const float*)(ws + O_STAT + (size_t)layer * STAT_BYTES), 0, (const float*)(ws + O_CSIN), (const float*)(ws + O_BWIN), u, wr, wc, lane, pf);
  }
  DI void operator()(const AccT& acc, const pg8::Unit& u, int wr, int wc, int fr, int fq, PfT& pf) const {
    const int l_ = tid_(wr * 4 + wc) & 63; fr = l_ & 15; fq = l_ >> 4;
    EPI_STAGE(smem, pf, wr * 4 + wc, l_)
    do_half<0>(acc, u, wr, wc, fr, fq, mean_, rstd_, lw_); do_half<1>(acc, u, wr, wc, fr, fq, mean_, rstd_, lw_);
  }
};
typedef EpiProj_<true> EpiProj;
struct EpiQ {
  static constexpr bool PERM = true, AFTER_DRAIN = false;
  unsigned char* ws; int L; unsigned char* smem;
  DI void prefetch(const pg8::Unit& u, int wr, int wc, int lane, PfT& pf) const {
    const float* stat = (const float*)(ws + O_STAT + (size_t)L * STAT_BYTES);
    const int ra = u.pm * 256 + wr * 64 + ((lane >> 4) & 3) * 16 + (lane & 15);
    pf[0] = ((const GAS float*)stat)[(size_t)ra * 8 + 4]; pf[1] = ((const GAS float*)stat)[(size_t)(ra + 128) * 8 + 4];
  }
  DI void operator()(const AccT& acc, const pg8::Unit& u, int wr, int wc, int fr, int fq, PfT& pf) const {
    const int l_ = tid_(wr * 4 + wc) & 63; fr = l_ & 15; fq = l_ >> 4;
    unsigned char* lw_ = smem + LDS_EPI + (wr * 4 + wc) * 1536;
    *(float*)(lw_ + l_ * 4) = rsqrtf(pf[0] * (1.f / 384.f) + RMS_EPS) * QSCALE; *(float*)(lw_ + (l_ + 64) * 4) = rsqrtf(pf[1] * (1.f / 384.f) + RMS_EPS) * QSCALE;
    float rs_[8];
#pragma unroll
    for (int q_ = 0; q_ < 8; ++q_) rs_[q_] = *(const float*)(lw_ + ((q_ >> 2) * 64 + (q_ & 3) * 16 + fr) * 4);
    half<0>(acc, u, wr, wc, fr, fq, rs_); half<1>(acc, u, wr, wc, fr, fq, rs_);
  }
  template <int bj> DI void half(const AccT& acc, const pg8::Unit& u, int wr, int wc, int fr, int fq, const float (&rs_)[8]) const {
    const float* stat = (const float*)(ws + O_STAT + (size_t)L * STAT_BYTES); const float* rope = (const float*)(ws + O_ROPE);
    const int b = u.pm >> 4, s0 = (u.pm & 15) * 256;
    {
      const int g32 = 8 * u.pn + 4 * bj + wc, head = g32 / 3, part = g32 - 3 * head;
      bf16_t* base = (bf16_t*)(ws + O_QF) + (size_t)((b * 8 + head) * 4096 + s0) * 96 + part * 32;
      if (part < 2) {
#pragma unroll
        for (int ai = 0; ai < 2; ++ai)
#pragma unroll
          for (int m = 0; m < 4; ++m) {
            const int rl = ai * 128 + wr * 64 + m * 16 + fr; const float rs = rs_[ai * 4 + m];
            const u32x2 lo_ = pk4(acc[ai][bj][m][0] * rs), hi_ = pk4(acc[ai][bj][m][1] * rs); u32x4 w_ = {lo_[0], lo_[1], hi_[0], hi_[1]};
            *(u32x4*)(base + rl * 96 + 8 * fq) = w_;
          }
      } else {
        const int lane = (fq << 4) | fr; const bool isx1 = fq < 2; const int ri = 8 * (fq & 1);
        const int row0 = u.pm * 256 + wr * 64 + fr;
        f32x4 cc[2], sc[2], cn[2], sn[2];
#pragma unroll
        for (int n = 0; n < 2; ++n) { cc[n] = *(const f32x4*)(rope + row0 * 32 + ri + 4 * n); sc[n] = *(const f32x4*)(rope + row0 * 32 + 16 + ri + 4 * n); cn[n] = cc[n]; sn[n] = sc[n]; }
#pragma unroll
        for (int q = 0; q < 8; ++q) {
          const int ai = q >> 2, m = q & 3, rl = ai * 128 + wr * 64 + m * 16 + fr;
          if (q < 7) { const int rown = row0 + ((q + 1) >> 2) * 128 + ((q + 1) & 3) * 16;
#pragma unroll
            for (int n = 0; n < 2; ++n) { cn[n] = *(const f32x4*)(rope + rown * 32 + ri + 4 * n); sn[n] = *(const f32x4*)(rope + rown * 32 + 16 + ri + 4 * n); } }
          const float rs = rs_[q];
          u32x4 w_;
#pragma unroll
          for (int n = 0; n < 2; ++n) {
            const f32x4 own = acc[ai][bj][m][n] * rs;
            f32x4 oth;
#pragma unroll
            for (int jj = 0; jj < 4; ++jj) oth[jj] = shx(own[jj], 32, lane);
            const f32x4 res = isx1 ? own * cc[n] - oth * sc[n] : own * cc[n] + oth * sc[n];
            const u32x2 h_ = pk4(res); w_[2 * n] = h_[0]; w_[2 * n + 1] = h_[1];
          }
          *(u32x4*)(base + rl * 96 + 8 * fq) = w_;
#pragma unroll
          for (int n = 0; n < 2; ++n) { cc[n] = cn[n]; sc[n] = sn[n]; }
        }
      }
    }
  }
};
struct EpiKV {
  static constexpr bool PERM = true, AFTER_DRAIN = false;
  unsigned char* ws; int L; unsigned char* smem;
  DI void prefetch(const pg8::Unit& u, int wr, int wc, int lane, PfT& pf) const {
    const float* stat = (const float*)(ws + O_STAT + (size_t)L * STAT_BYTES);
    const int ra = u.pm * 256 + wr * 64 + ((lane >> 4) & 3) * 16 + (lane & 15);
    pf[0] = ((const GAS float*)stat)[(size_t)ra * 8 + 5]; pf[1] = ((const GAS float*)stat)[(size_t)(ra + 128) * 8 + 5];
  }
  DI void operator()(const AccT& acc, const pg8::Unit& u, int wr, int wc, int fr, int fq, PfT& pf) const {
    const int l_ = tid_(wr * 4 + wc) & 63; fr = l_ & 15; fq = l_ >> 4;
    unsigned char* lw_ = smem + LDS_EPI + (wr * 4 + wc) * 1536;
    *(float*)(lw_ + l_ * 4) = rsqrtf(pf[0] * (1.f / 256.f) + RMS_EPS); *(float*)(lw_ + (l_ + 64) * 4) = rsqrtf(pf[1] * (1.f / 256.f) + RMS_EPS);
    float rs_[8];
#pragma unroll
    for (int q_ = 0; q_ < 8; ++q_) rs_[q_] = *(const float*)(lw_ + ((q_ >> 2) * 64 + (q_ & 3) * 16 + fr) * 4);
    half<0>(acc, u, wr, wc, fr, fq, rs_); half<1>(acc, u, wr, wc, fr, fq, rs_);
  }
  template <int bj> DI void half(const AccT& acc, const pg8::Unit& u, int wr, int wc, int fr, int fq, const float (&rs_)[8]) const {
    const float* stat = (const float*)(ws + O_STAT + (size_t)L * STAT_BYTES);
    const int b = u.pm >> 4, s0 = (u.pm & 15) * 256, head = 2 * u.pn + bj;
    bf16_t* base = wc < 2 ? (bf16_t*)(ws + O_KF) + (size_t)((b * 8 + head) * 4096 + s0) * 96 + 32 * wc : (bf16_t*)(ws + O_VT) + (size_t)((b * 8 + head) * 4096 + s0) * 64 + 32 * (wc - 2);
    const int ld = wc < 2 ? 96 : 64;
#pragma unroll
    for (int ai = 0; ai < 2; ++ai)
#pragma unroll
      for (int m = 0; m < 4; ++m) {
        const int rl = ai * 128 + wr * 64 + m * 16 + fr;
        const float rs = rs_[ai * 4 + m];
        bf16_t* dst = base + rl * ld + 8 * fq;
        { const u32x2 lo_ = pk4(acc[ai][bj][m][0] * rs), hi_ = pk4(acc[ai][bj][m][1] * rs); u32x4 w_ = {lo_[0], lo_[1], hi_[0], hi_[1]}; *(u32x4*)dst = w_; }
      }
  }
};
struct EpiOut {
  static constexpr bool PERM = true, AFTER_DRAIN = false;
  const Params& P; unsigned char* ws; int L; unsigned char* smem;
  DI EpiOut(const Params& P_, unsigned char* w, int L_, unsigned char* sm) : P(P_), ws(w), L(L_), smem(sm) {}
  DI void prefetch(const pg8::Unit& u, int wr, int wc, int lane, PfT& pf) const {
    const float* g = L == 0 ? IN_(ws, I_LNING) : IN_(ws, I_LN2G) + (size_t)(L - 1) * 1024; const float* b = L == 0 ? IN_(ws, I_LNINB) : IN_(ws, I_LN2B) + (size_t)(L - 1) * 1024;
    epi_prefetch((const float*)(ws + O_STAT + (size_t)L * STAT_BYTES), 0, g, b, u, wr, wc, lane, pf);
  }
  DI void operator()(const AccT& acc, const pg8::Unit& u, int wr, int wc, int fr, int fq, PfT& pf) const {
    const int l_ = tid_(wr * 4 + wc) & 63; fr = l_ & 15; fq = l_ >> 4;
    const float* src = L == 0 ? IN_(ws, I_X) : OUT_(ws); float* out = OUT_(ws); float* stat = (float*)(ws + O_STAT + (size_t)L * STAT_BYTES);
    bf16_t* YB = (bf16_t*)(ws + O_AB);
    const int row0 = u.pm * 256 + wr * 64 + fr;
    EPI_STAGE(smem, pf, wr * 4 + wc, l_)
#pragma unroll
    for (int bj = 0; bj < 2; ++bj) {
      const int c0 = u.pn * 256 + 128 * bj + wc * 32 + 8 * fq;
      const f32x4 g0 = EPI_COLA_P(bj, 0), g1 = EPI_COLA_P(bj, 1), b0 = EPI_COLB_P(bj, 0), b1 = EPI_COLB_P(bj, 1);
      f32x4 xc0 = __builtin_nontemporal_load((const GAS f32x4*)(src + (size_t)row0 * 1024 + c0)), xc1 = __builtin_nontemporal_load((const GAS f32x4*)(src + (size_t)row0 * 1024 + c0 + 4)), xn0 = xc0, xn1 = xc1;
#pragma unroll
      for (int q = 0; q < 8; ++q) {
        const int ai = q >> 2, m = q & 3, row = row0 + ai * 128 + m * 16;
        if (q < 7) { const int rown = row0 + ((q + 1) >> 2) * 128 + ((q + 1) & 3) * 16; xn0 = __builtin_nontemporal_load((const GAS f32x4*)(src + (size_t)rown * 1024 + c0)); xn1 = __builtin_nontemporal_load((const GAS f32x4*)(src + (size_t)rown * 1024 + c0 + 4)); }
        const float mean = mean_[q], rstd = rstd_[q];
        const size_t o = (size_t)row * 1024 + c0;
        const f32x4 y0 = ((xc0 - mean) * rstd * g0 + b0) * ALPHA + acc[ai][bj][m][0], y1 = ((xc1 - mean) * rstd * g1 + b1) * ALPHA + acc[ai][bj][m][1];
        __builtin_nontemporal_store(y0, (GAS f32x4*)(out + o)); __builtin_nontemporal_store(y1, (GAS f32x4*)(out + o + 4)); { const u32x2 lo_ = pk4(y0), hi_ = pk4(y1); u32x4 w_ = {lo_[0], lo_[1], hi_[0], hi_[1]}; *(u32x4*)(YB + o) = w_; }
        float s1 = y0[0] + y0[1] + y0[2] + y0[3] + y1[0] + y1[1] + y1[2] + y1[3];
        float s2 = y0[0] * y0[0] + y0[1] * y0[1] + y0[2] * y0[2] + y0[3] * y0[3] + y1[0] * y1[0] + y1[1] * y1[1] + y1[2] * y1[2] + y1[3] * y1[3];
        s1 = xor_sum_fq(s1); s2 = xor_sum_fq(s2);
        if (fq == 0) { atomicAdd(stat + (size_t)row * 8 + 2, s1); atomicAdd(stat + (size_t)row * 8 + 3, s2); }
        xc0 = xn0; xc1 = xn1;
      }
    }
  }
};
struct EpiPle {
  static constexpr bool PERM = true, AFTER_DRAIN = false;
  unsigned char* ws;
  DI void prefetch(const pg8::Unit&, int, int, int, PfT&) const {}
  DI void operator()(const AccT& acc, const pg8::Unit& u, int wr, int wc, int fr, int fq, PfT& pf) const {
    { const int l_ = tid_(wr * 4 + wc) & 63; fr = l_ & 15; fq = l_ >> 4; }
    const int c0 = u.pn * 256 + wc * 32 + 8 * fq; bf16_t* PLE = (bf16_t*)(ws + O_PLE);
#pragma unroll
    for (int ai = 0; ai < 2; ++ai)
#pragma unroll
      for (int m = 0; m < 4; ++m) {
        const int row = u.pm * 256 + ai * 128 + wr * 64 + m * 16 + fr;
#pragma unroll
        for (int bj = 0; bj < 2; ++bj) { const u32x2 lo_ = pk4(acc[ai][bj][m][0]), hi_ = pk4(acc[ai][bj][m][1]); u32x4 w_ = {lo_[0], lo_[1], hi_[0], hi_[1]};
          *(u32x4*)(PLE + (size_t)row * 1024 + c0 + 128 * bj) = w_; }
      }
  }
};
template <int MODE> struct EpiGU_ {
  static constexpr bool PERM = true, AFTER_DRAIN = false;
  unsigned char* ws; int L; unsigned char* smem;
  DI void prefetch(const pg8::Unit& u, int wr, int wc, int lane, PfT& pf) const {
    epi_prefetch((const float*)(ws + O_STAT + (size_t)L * STAT_BYTES), 2, (const float*)(ws + O_CSGU), (const float*)(ws + O_BWGU), u, wr, wc, lane, pf);
  }
  DI void operator()(const AccT& acc, const pg8::Unit& u, int wr, int wc, int fr, int fq, PfT& pf) const {
    const int l_ = tid_(wr * 4 + wc) & 63; fr = l_ & 15; fq = l_ >> 4;
    const float* stat = (const float*)(ws + O_STAT + (size_t)L * STAT_BYTES); const float* cs = (const float*)(ws + O_CSGU); const float* bw = (const float*)(ws + O_BWGU);
    bf16_t* ACT = (bf16_t*)(ws + O_ACT); bf16_t* PLE = (bf16_t*)(ws + O_PLE);
    const int c0 = u.pn * 256 + wc * 32 + 8 * fq;
    const int row0 = u.pm * 256 + wr * 64 + fr;
    EPI_STAGE(smem, pf, wr * 4 + wc, l_)
    f32x4 csv[2][2], bwv[2][2];
#pragma unroll
    for (int bj = 0; bj < 2; ++bj)
#pragma unroll
      for (int n = 0; n < 2; ++n) { csv[bj][n] = EPI_COLA_P(bj, n); bwv[bj][n] = EPI_COLB_P(bj, n); }
    if (u.pn < 22) {
#pragma unroll
      for (int q = 0; q < 8; ++q) {
        const int ai = q >> 2, m = q & 3, row = row0 + ai * 128 + m * 16;
        const float mean = mean_[q], rstd = rstd_[q];
        u32x4 w_;
#pragma unroll
        for (int n = 0; n < 2; ++n) {
          const f32x4 gt = (acc[ai][0][m][n] - csv[0][n] * mean) * rstd + bwv[0][n];
          const f32x4 up = (acc[ai][1][m][n] - csv[1][n] * mean) * rstd + bwv[1][n];
          f32x4 a;
#pragma unroll
          for (int j = 0; j < 4; ++j) a[j] = siluf_(gt[j]) * up[j];
          const u32x2 h_ = pk4(a); w_[2 * n] = h_[0]; w_[2 * n + 1] = h_[1];
        }
        if (MODE == 0) *(u32x4*)(ACT + (size_t)row * DFF + u.pn * 128 + wc * 32 + 8 * fq) = w_;
        else *(u32x4*)((bf16_t*)(ws + O_MIX) + (size_t)row * 1024 + ((u.pn * 128 + wc * 32 + 8 * fq) & 1023)) = w_;
      }
    } else {
      u32x2 pc[4], pn_[4];
#pragma unroll
      for (int t = 0; t < 4; ++t) pc[t] = *(const u32x2*)(PLE + (size_t)row0 * 1024 + (c0 - 2 * DFF) + 128 * (t >> 1) + 4 * (t & 1));
#pragma unroll
      for (int q = 0; q < 8; ++q) {
        const int ai = q >> 2, m = q & 3, row = row0 + ai * 128 + m * 16;
        if (q < 7) { const int rown = row0 + ((q + 1) >> 2) * 128 + ((q + 1) & 3) * 16;
#pragma unroll
          for (int t = 0; t < 4; ++t) pn_[t] = *(const u32x2*)(PLE + (size_t)rown * 1024 + (c0 - 2 * DFF) + 128 * (t >> 1) + 4 * (t & 1)); }
        const float mean = mean_[q], rstd = rstd_[q];
#pragma unroll
        for (int t = 0; t < 4; ++t) {
          const int bj = t >> 1, n = t & 1;
          const f32x4 v = (acc[ai][bj][m][n] - csv[bj][n] * mean) * rstd + bwv[bj][n];
          const f32x4 pl = unpk4(pc[t]);
          f32x4 o;
#pragma unroll
          for (int j = 0; j < 4; ++j) o[j] = sigmoidf_(v[j]) * pl[j];
          *(u32x2*)(PLE + (size_t)row * 1024 + (c0 - 2 * DFF) + 128 * bj + 4 * n) = pk4(o);
        }
#pragma unroll
        for (int t = 0; t < 4; ++t) pc[t] = pn_[t];
      }
    }
  }
};
typedef EpiGU_<0> EpiGU;
struct EpiDown {
  static constexpr bool PERM = true, AFTER_DRAIN = false;
  const Params& P; unsigned char* ws; int L; unsigned char* smem;
  DI EpiDown(const Params& P_, unsigned char* w, int L_, unsigned char* sm) : P(P_), ws(w), L(L_), smem(sm) {}
  DI void prefetch(const pg8::Unit& u, int wr, int wc, int lane, PfT& pf) const {
    epi_prefetch((const float*)(ws + O_STAT + (size_t)L * STAT_BYTES), 2, IN_(ws, I_LN1G) + (size_t)L * 1024, IN_(ws, I_LN1B) + (size_t)L * 1024, u, wr, wc, lane, pf);
  }
  DI void operator()(const AccT& acc, const pg8::Unit& u, int wr, int wc, int fr, int fq, PfT& pf) const {
    const int l_ = tid_(wr * 4 + wc) & 63; fr = l_ & 15; fq = l_ >> 4;
    float* out = OUT_(ws); const float* stat = (const float*)(ws + O_STAT + (size_t)L * STAT_BYTES); float* stat_next = (float*)(ws + O_STAT + (size_t)(L + 1) * STAT_BYTES);
    const bf16_t* PLE = (const bf16_t*)(ws + O_PLE); bf16_t* ZB = (bf16_t*)(ws + O_AB);
    const int row0 = u.pm * 256 + wr * 64 + fr;
    EPI_STAGE(smem, pf, wr * 4 + wc, l_)
#pragma unroll
    for (int bj = 0; bj < 2; ++bj) {
      const int c0 = u.pn * 256 + 128 * bj + wc * 32 + 8 * fq;
      const f32x4 g0 = EPI_COLA_P(bj, 0), g1 = EPI_COLA_P(bj, 1), b0 = EPI_COLB_P(bj, 0), b1 = EPI_COLB_P(bj, 1);
      f32x4 yc0 = __builtin_nontemporal_load((const GAS f32x4*)(out + (size_t)row0 * 1024 + c0)), yc1 = __builtin_nontemporal_load((const GAS f32x4*)(out + (size_t)row0 * 1024 + c0 + 4)), yn0 = yc0, yn1 = yc1;
      u32x2 pc0 = __builtin_nontemporal_load((const GAS u32x2*)(PLE + (size_t)row0 * 1024 + c0)), pc1 = __builtin_nontemporal_load((const GAS u32x2*)(PLE + (size_t)row0 * 1024 + c0 + 4)), pn0 = pc0, pn1 = pc1;
#pragma unroll
      for (int q = 0; q < 8; ++q) {
        const int ai = q >> 2, m = q & 3, row = row0 + ai * 128 + m * 16;
        if (q < 7) { const size_t on = (size_t)(row0 + ((q + 1) >> 2) * 128 + ((q + 1) & 3) * 16) * 1024 + c0;
          yn0 = __builtin_nontemporal_load((const GAS f32x4*)(out + on)); yn1 = __builtin_nontemporal_load((const GAS f32x4*)(out + on + 4)); pn0 = __builtin_nontemporal_load((const GAS u32x2*)(PLE + on)); pn1 = __builtin_nontemporal_load((const GAS u32x2*)(PLE + on + 4)); }
        const float mean = mean_[q], rstd = rstd_[q];
        const size_t o = (size_t)row * 1024 + c0;
        const f32x4 z0 = ((yc0 - mean) * rstd * g0 + b0) * ALPHA + acc[ai][bj][m][0] + unpk4(pc0), z1 = ((yc1 - mean) * rstd * g1 + b1) * ALPHA + acc[ai][bj][m][1] + unpk4(pc1);
        __builtin_nontemporal_store(z0, (GAS f32x4*)(out + o)); __builtin_nontemporal_store(z1, (GAS f32x4*)(out + o + 4)); if (L == 0) { const u32x2 lo_ = pk4(z0), hi_ = pk4(z1); u32x4 w_ = {lo_[0], lo_[1], hi_[0], hi_[1]}; *(u32x4*)(ZB + o) = w_; }
        float s1 = z0[0] + z0[1] + z0[2] + z0[3] + z1[0] + z1[1] + z1[2] + z1[3];
        float s2 = z0[0] * z0[0] + z0[1] * z0[1] + z0[2] * z0[2] + z0[3] * z0[3] + z1[0] * z1[0] + z1[1] * z1[1] + z1[2] * z1[2] + z1[3] * z1[3];
        s1 = xor_sum_fq(s1); s2 = xor_sum_fq(s2);
        if (fq == 0) { atomicAdd(stat_next + (size_t)row * 8 + 0, s1); atomicAdd(stat_next + (size_t)row * 8 + 1, s2); }
        yc0 = yn0; yc1 = yn1; pc0 = pn0; pc1 = pn1;
      }
    }
  }
};
struct EpiNull { static constexpr bool PERM = false, AFTER_DRAIN = false;
  DI void prefetch(const pg8::Unit&, int, int, int, PfT&) const {}
  DI void operator()(const AccT& acc, const pg8::Unit& u, int wr, int wc, int fr, int fq, PfT& pf) const { f32x4 t = {0.f, 0.f, 0.f, 0.f};
#pragma unroll
    for (int a = 0; a < 2; ++a)
#pragma unroll
      for (int b = 0; b < 2; ++b)
#pragma unroll
        for (int m = 0; m < 4; ++m)
#pragma unroll
          for (int n = 0; n < 2; ++n) t += acc[a][b][m][n];
    if (t[0] + t[1] + t[2] + t[3] == 1.2345e-30f) __builtin_amdgcn_s_sleep(1); } };
template <class Epi> DI void run_gemm(unsigned char* smem, const bf16_t* A, const bf16_t* Bt, int M, int N, int K, const Epi& E, int wv) {
  pg8::StaticOrder S; S.init(M, N, nblk_(), (int)bid_());
  int Kx = K; asm volatile("" : "+s"(Kx));
  pg8::Gemm g; g.A = A; g.Bt = Bt; g.M = M; g.N = N; g.K = Kx;
  __syncthreads();
  pg8::gemm_phase<Epi, pg8::StaticOrder>((LAS unsigned char*)smem, g, S, E, wv);
  __syncthreads();
}
DI void sgu_item(const Params& P, int L, int item, unsigned char* smem, int wv) {
  unsigned char* ws = P.ws; LAUNDER_G(ws);
  const int tid = tid_(wv), lane = tid & 63, wid = wv, r = lane & 31, hh = lane >> 5;
  const int chunk = item >> 2, grp = item & 3, tok0 = chunk * 128;
  const bf16_t* GV = (const bf16_t*)(ws + O_GV); const bf16_t* GU = (const bf16_t*)(ws + O_GU); bf16_t* MIX = (bf16_t*)(ws + O_MIX);
  const float* stat = (const float*)(ws + O_STAT + (size_t)L * STAT_BYTES);
  bf16_t* sVl = (bf16_t*)smem;
  __syncthreads();
  const int tb = wid >> 1, cb = wid & 1, nks = 2 * (tb + 1);
  const bf16_t* Wg = (const bf16_t*)(ws + O_WS) + (size_t)grp * 128 * 128 + (size_t)(32 * tb + r) * 128 + 8 * hh;
  bf16x8 a[8];
#pragma unroll
  for (int ks = 0; ks < 8; ++ks) { if (ks < nks) a[ks] = *(const bf16x8*)(Wg + 16 * ks); else a[ks] = (bf16x8){0, 0, 0, 0, 0, 0, 0, 0}; }
  float uu[16];
#pragma unroll
  for (int i = 0; i < 16; ++i) uu[i] = bf2f(GU[(size_t)(tok0 + 32 * tb + crow(i, hh)) * 256 + grp * 64 + 32 * cb + r]);
  { const int s = tid >> 2, part = tid & 3;
    const float sm = stat[(size_t)(tok0 + s) * 8 + 6], sq = stat[(size_t)(tok0 + s) * 8 + 7];
    const float mean = sm * (1.f / 256.f), rstd = rsqrtf(fmaxf(sq * (1.f / 256.f) - mean * mean, 0.f) + LN_EPS);
    const bf16_t* gp = GV + (size_t)(tok0 + s) * 256 + grp * 64 + part * 16;
    const u32x4 g0 = *(const u32x4*)gp, g1 = *(const u32x4*)(gp + 8);
    const float* lgp = IN_(ws, I_SLNG) + L * 256 + grp * 64 + part * 16; const float* lbp = IN_(ws, I_SLNB) + L * 256 + grp * 64 + part * 16;
#pragma unroll
    for (int i = 0; i < 8; ++i) {
      const unsigned w = i < 4 ? g0[i & 3] : g1[i & 3];
      const float v0 = __uint_as_float(w << 16), v1 = __uint_as_float(w & 0xffff0000u);
      sVl[(part * 16 + 2 * i) * 136 + s] = f2bf((v0 - mean) * rstd * lgp[2 * i] + lbp[2 * i]);
      sVl[(part * 16 + 2 * i + 1) * 136 + s] = f2bf((v1 - mean) * rstd * lgp[2 * i + 1] + lbp[2 * i + 1]);
    } }
  __syncthreads();
  const float* bs = IN_(ws, I_SBS) + (size_t)L * 512 + grp * 128 + 32 * tb;
  f32x16 c; for (int i = 0; i < 16; ++i) c[i] = 0.f;
#pragma unroll
  for (int ks = 0; ks < 8; ++ks) if (ks < nks) c = MFMA32(a[ks], *(const bf16x8*)(sVl + (32 * cb + r) * 136 + 16 * ks + 8 * hh), c);
#pragma unroll
  for (int i = 0; i < 16; ++i) {
    const int t = crow(i, hh);
    MIX[(size_t)(tok0 + 32 * tb + t) * 1024 + 256 + grp * 64 + 32 * cb + r] = f2bf(uu[i] * (c[i] + bs[t]));
  }
  __syncthreads();
}

template <int STEP> DI void hgrn_item(const Params& P, int L, int pair, unsigned char* smem0, int wv) {
  unsigned char* ws = P.ws; LAUNDER_G(ws);
  const int tid = tid_(wv), lane = tid & 63, wid = wv, r = lane & 31, hh = lane >> 5;
  const int half = wid >> 2, hw = wid & 3, ht = tid & 255;
  const int item = pair * 2 + half;
  const int n = item & 63, bh = item >> 6, b = bh >> 2, h = bh & 3;
  const int tok0 = b * 4096 + n * 64, col0 = h * 64;
  const float* LF = (const float*)(ws + O_LF); const bf16_t* QH = (const bf16_t*)(ws + O_QH); const bf16_t* KH = (const bf16_t*)(ws + O_KH);
  const bf16_t* VH = (const bf16_t*)(ws + O_VH); const bf16_t* GS = (const bf16_t*)(ws + O_GS);
  unsigned char* smem = smem0 + half * 65536;
  float* sB = (float*)smem;
  float* sSeg = (float*)(smem + 16640);
  bf16_t* sA = (bf16_t*)(smem + 18944);
  bf16_t* sQ = (bf16_t*)(smem + 28160);
  bf16_t* sVt = (bf16_t*)(smem + 37376);
  bf16_t* sS = (bf16_t*)(smem + 46592);
  bf16_t* sP = (bf16_t*)(smem + 55808);
  const int k = ht & 63, seg = wv & 3;
  __syncthreads();
  unsigned short gV[16], gK[16], gQ[16];
#pragma unroll
  for (int i = 0; i < 16; ++i) { const size_t o = (size_t)(tok0 + seg * 16 + i) * 256 + col0 + k; gV[i] = VH[o]; gK[i] = KH[o]; gQ[i] = (STEP == 3) ? QH[o] : (unsigned short)0; }
  u32x4 gS[2] = {{0u, 0u, 0u, 0u}, {0u, 0u, 0u, 0u}};
  if (STEP == 3) {
#pragma unroll
    for (int pp = 0; pp < 2; ++pp) { const int p = ht + 256 * pp, v = p >> 3, part = p & 7; gS[pp] = *(const u32x4*)((const bf16_t*)(ws + O_SP) + (size_t)item * 4096 + v * 64 + part * 8); }
  }
  { float v[16]; float run = 0.f;
#pragma unroll
    for (int i = 0; i < 16; ++i) v[i] = LF[(size_t)(tok0 + seg * 16 + i) * 256 + col0 + k];
#pragma unroll
    for (int i = 0; i < 16; ++i) { run += v[i]; v[i] = run; }
    sSeg[seg * 64 + k] = run; __syncthreads();
    float pre = 0.f;
#pragma unroll
    for (int s = 0; s < 4; ++s) if (s < seg) pre += sSeg[s * 64 + k];
#pragma unroll
    for (int i = 0; i < 16; ++i) sB[(seg * 16 + i) * 65 + k] = v[i] + pre;
  }
#pragma unroll
  for (int i = 0; i < 16; ++i) { const int s = seg * 16 + i; sVt[k * 72 + s] = gV[i]; }
  __syncthreads();
  if (STEP == 1) {
    const float bl = sB[63 * 65 + k];
#pragma unroll
    for (int i = 0; i < 16; ++i) { const int s = seg * 16 + i; const float kk = bf2f(gK[i]); sA[k * 72 + s] = f2bf(kk * __expf(bl - sB[s * 65 + k])); }
    if (seg == 0) { ((float*)(ws + O_DEC))[(size_t)item * 64 + k] = __expf(bl); ((float*)(ws + O_EREF))[(size_t)item * 64 + k] = __expf(sB[31 * 65 + k]); }
    __syncthreads();
    {
      const int vb = hw >> 1, kb = hw & 1;
      f32x16 c; for (int i = 0; i < 16; ++i) c[i] = 0.f;
#pragma unroll
      for (int ks = 0; ks < 4; ++ks) {
        const bf16x8 a = *(const bf16x8*)(sVt + (32 * vb + r) * 72 + 16 * ks + 8 * hh);
        const bf16x8 bb = *(const bf16x8*)(sA + (32 * kb + r) * 72 + 16 * ks + 8 * hh);
        c = MFMA32(a, bb, c);
      }
      float* dst = (float*)(ws + O_CKVT) + (size_t)item * 4096;
#pragma unroll
      for (int i = 0; i < 16; ++i) dst[(32 * vb + crow(i, hh)) * 64 + 32 * kb + r] = c[i];
    }
  } else {
    const float br = sB[31 * 65 + k];
#pragma unroll
    for (int i = 0; i < 16; ++i) {
      const int t = seg * 16 + i; const float bt = sB[t * 65 + k];
      const float qq = bf2f(gQ[i]), kk = bf2f(gK[i]);
      sQ[t * 72 + k] = f2bf(qq * __expf(bt - br));
      sA[t * 72 + k] = f2bf(kk * __expf(br - bt));
    }
#pragma unroll
    for (int pp = 0; pp < 2; ++pp) { const int p = ht + 256 * pp, v = p >> 3, part = p & 7;
      *(u32x4*)(sS + v * 72 + part * 8) = gS[pp]; }
    __syncthreads();
    {
      const int sb = hw >> 1, tb = hw & 1;
      f32x16 c; for (int i = 0; i < 16; ++i) c[i] = 0.f;
      if (!(sb == 1 && tb == 0)) {
#pragma unroll
        for (int ks = 0; ks < 4; ++ks) {
          const bf16x8 a = *(const bf16x8*)(sA + (32 * sb + r) * 72 + 16 * ks + 8 * hh);
          const bf16x8 bb = *(const bf16x8*)(sQ + (32 * tb + r) * 72 + 16 * ks + 8 * hh);
          c = MFMA32(a, bb, c);
        }
      }
      const int t = 32 * tb + r;
#pragma unroll
      for (int g = 0; g < 4; ++g) {
        f32x4 v;
#pragma unroll
        for (int j = 0; j < 4; ++j) { const int s = 32 * sb + 8 * g + 4 * hh + j; v[j] = (s <= t) ? c[4 * g + j] : 0.f; }
        *(u32x2*)(sP + t * 72 + 32 * sb + 8 * g + 4 * hh) = pk4(v);
      }
    }
    __syncthreads();
    if (hw < 2) {
      const int tb = hw, t = 32 * tb + r;
      f32x16 c0, c1; for (int i = 0; i < 16; ++i) { c0[i] = 0.f; c1[i] = 0.f; }
#pragma unroll
      for (int ks = 0; ks < 4; ++ks) {
        const bf16x8 bp = *(const bf16x8*)(sP + t * 72 + 16 * ks + 8 * hh);
        const bf16x8 bq = *(const bf16x8*)(sQ + t * 72 + 16 * ks + 8 * hh);
        c0 = MFMA32(*(const bf16x8*)(sVt + r * 72 + 16 * ks + 8 * hh), bp, c0);
        c1 = MFMA32(*(const bf16x8*)(sVt + (32 + r) * 72 + 16 * ks + 8 * hh), bp, c1);
        c0 = MFMA32(*(const bf16x8*)(sS + r * 72 + 16 * ks + 8 * hh), bq, c0);
        c1 = MFMA32(*(const bf16x8*)(sS + (32 + r) * 72 + 16 * ks + 8 * hh), bq, c1);
      }
      float ss = 0.f;
#pragma unroll
      for (int i = 0; i < 16; ++i) ss += c0[i] * c0[i] + c1[i] * c1[i];
      ss += shx(ss, 32, lane);
      const float rn = rsqrtf(ss * (1.f / 64.f) + RMS_EPS);
      const float* ng = IN_(ws, I_HNG) + L * 256 + col0;
      bf16_t* MIX = (bf16_t*)(ws + O_MIX);
#pragma unroll
      for (int vb = 0; vb < 2; ++vb)
#pragma unroll
        for (int g = 0; g < 4; ++g) {
          const int v0 = 32 * vb + 8 * g + 4 * hh;
          const f32x4 gs = unpk4(*(const u32x2*)(GS + (size_t)(tok0 + t) * 256 + col0 + v0));
          const f32x4 nv = *(const f32x4*)(ng + v0);
          f32x4 o;
#pragma unroll
          for (int j = 0; j < 4; ++j) o[j] = (vb == 0 ? c0[4 * g + j] : c1[4 * g + j]) * rn * nv[j] * gs[j];
          *(u32x2*)(MIX + (size_t)(tok0 + t) * 1024 + col0 + v0) = pk4(o);
        }
    }
  }
  __syncthreads();
}

DI void hgrn_scan(const Params& P, int bh, int wv) {
  unsigned char* ws = P.ws; LAUNDER_G(ws);
  const int tid = tid_(wv), k = tid & 63, vq = wv;
  const float* __restrict__ DEC = (const float*)(ws + O_DEC) + (size_t)bh * 64 * 64; const float* __restrict__ EREF = (const float*)(ws + O_EREF) + (size_t)bh * 64 * 64;
  const float* __restrict__ CKVT = (const float*)(ws + O_CKVT) + (size_t)bh * 64 * 4096; bf16_t* __restrict__ SP = (bf16_t*)(ws + O_SP) + (size_t)bh * 64 * 4096;
  float S[8];
#pragma unroll
  for (int i = 0; i < 8; ++i) S[i] = 0.f;
  float dc[8], ec[8], kc[8][8];
#define SC_LOAD(D, E, K, nb_) do { _Pragma("unroll") for (int j = 0; j < 8; ++j) { const int n = (nb_) * 8 + j; D[j] = DEC[n * 64 + k]; E[j] = EREF[n * 64 + k]; \
    _Pragma("unroll") for (int i = 0; i < 8; ++i) K[j][i] = CKVT[(size_t)n * 4096 + (vq * 8 + i) * 64 + k]; } } while (0)
  SC_LOAD(dc, ec, kc, 0);
#pragma unroll 1
  for (int nb = 0; nb < 8; ++nb) {
    float dn[8], en[8], kn[8][8];
    if (nb + 1 < 8) SC_LOAD(dn, en, kn, nb + 1);
    else {
#pragma unroll
      for (int j = 0; j < 8; ++j) { dn[j] = 0.f; en[j] = 0.f;
#pragma unroll
        for (int i = 0; i < 8; ++i) kn[j][i] = 0.f; }
    }
#pragma unroll
    for (int j = 0; j < 8; ++j) {
      const int n = nb * 8 + j;
#pragma unroll
      for (int i = 0; i < 8; ++i) { SP[(size_t)n * 4096 + (vq * 8 + i) * 64 + k] = f2bf(ec[j] * S[i]); S[i] = dc[j] * S[i] + kc[j][i]; }
    }
#pragma unroll
    for (int j = 0; j < 8; ++j) { dc[j] = dn[j]; ec[j] = en[j];
#pragma unroll
      for (int i = 0; i < 8; ++i) kc[j][i] = kn[j][i]; }
  }
#undef SC_LOAD
}

constexpr int AT_KB = 26624, AT_VB = 17408, AT_VOFF = 2 * AT_KB;
DI void attn_unit(const Params& P, int bh, int qb, unsigned char* smem, int wv) {
  unsigned char* ws = P.ws; LAUNDER_G(ws);
  const int tid = tid_(wv), lane = tid & 63, wid = wv, r = lane & 31, hh = lane >> 5;
  const int sq = 256 * qb + 32 * wid + r;
  const bf16_t* QF = (const bf16_t*)(ws + O_QF); const bf16_t* kbase = (const bf16_t*)(ws + O_KF) + (size_t)bh * 4096 * 96;
  const bf16_t* vbase = (const bf16_t*)(ws + O_VT) + (size_t)bh * 4096 * 64;
  bf16x8 qf[6];
  { const bf16_t* qp = QF + ((size_t)bh * 4096 + sq) * 96 + 8 * hh;
#pragma unroll
    for (int ds = 0; ds < 6; ++ds) qf[ds] = *(const bf16x8*)(qp + 16 * ds); }
  f32x16 o0, o1; for (int i = 0; i < 16; ++i) { o0[i] = 0.f; o1[i] = 0.f; }
  float mrun = 0.f, lrun = 0.f;
  const int nt = 2 * qb + 2, ktmax = 2 * qb + (wid >> 2);
  int kr[3], kc[3];
#pragma unroll
  for (int i = 0; i < 3; ++i) { const int p = tid + 512 * i; kr[i] = p / 12; kc[i] = p - 12 * kr[i]; }
  const int vkey = tid & 127, vpart = tid >> 7;
  const int vkp = (vkey & ~15) | ((vkey & 3) | ((vkey & 4) << 1) | ((vkey & 8) >> 1));
  u32x4 rk[3], rv[2];
#define AT_GLOAD(kt) do { const bf16_t* kp = kbase + (size_t)(kt) * 128 * 96; _Pragma("unroll") for (int i = 0; i < 3; ++i) rk[i] = *(const u32x4*)(kp + kr[i] * 96 + kc[i] * 8); \
    _Pragma("unroll") for (int i = 0; i < 2; ++i) rv[i] = *(const u32x4*)(vbase + (size_t)((kt) * 128 + vkey) * 64 + (vpart + 4 * i) * 8); } while (0)
#define AT_SWRITE(buf) do { unsigned char* kd = smem + (buf) * AT_KB; _Pragma("unroll") for (int i = 0; i < 3; ++i) *(u32x4*)(kd + kr[i] * 208 + kc[i] * 16) = rk[i]; \
    _Pragma("unroll") for (int i = 0; i < 2; ++i) { bf16_t* vd = (bf16_t*)(smem + AT_VOFF + (buf) * AT_VB) + ((vpart + 4 * i) * 8) * 136 + vkp; \
      vd[0] = (bf16_t)(rv[i][0] & 0xffffu); vd[136] = (bf16_t)(rv[i][0] >> 16); vd[272] = (bf16_t)(rv[i][1] & 0xffffu); vd[408] = (bf16_t)(rv[i][1] >> 16); \
      vd[544] = (bf16_t)(rv[i][2] & 0xffffu); vd[680] = (bf16_t)(rv[i][2] >> 16); vd[816] = (bf16_t)(rv[i][3] & 0xffffu); vd[952] = (bf16_t)(rv[i][3] >> 16); } } while (0)
  __syncthreads();
  AT_GLOAD(0); AT_SWRITE(0); __syncthreads();
#pragma unroll 1
  for (int kt = 0; kt < nt; ++kt) {
    const int cur = kt & 1;
    if (kt + 1 < nt) AT_GLOAD(kt + 1);
    if (kt <= ktmax) {
      const unsigned char* Kb = smem + cur * AT_KB; const unsigned char* Vb = smem + AT_VOFF + cur * AT_VB;
      const int nkb = (kt == ktmax) ? (wid & 3) + 1 : 4;
      f32x16 p[4];
      const float ninit = -mrun;
      f32x16 cinit; for (int i = 0; i < 16; ++i) cinit[i] = ninit;
      if (kt != ktmax) {
#pragma unroll
        for (int kb = 0; kb < 4; ++kb) p[kb] = MFMA32(*(const bf16x8*)(Kb + (32 * kb + r) * 208 + hh * 16), qf[0], cinit);
#pragma unroll
        for (int ds = 1; ds < 6; ++ds)
#pragma unroll
          for (int kb = 0; kb < 4; ++kb) p[kb] = MFMA32(*(const bf16x8*)(Kb + (32 * kb + r) * 208 + ds * 32 + hh * 16), qf[ds], p[kb]);
      } else
#pragma unroll
      for (int kb = 0; kb < 4; ++kb) {
        if (kb < nkb) {
          p[kb] = MFMA32(*(const bf16x8*)(Kb + (32 * kb + r) * 208 + hh * 16), qf[0], cinit);
#pragma unroll
          for (int ds = 1; ds < 6; ++ds) p[kb] = MFMA32(*(const bf16x8*)(Kb + (32 * kb + r) * 208 + ds * 32 + hh * 16), qf[ds], p[kb]);
          if (kt == ktmax && kb == nkb - 1) {
            const int lim = sq - 128 * kt - 32 * kb - 4 * hh;
#pragma unroll
            for (int i = 0; i < 16; ++i) if ((i & 3) + 8 * (i >> 2) > lim) p[kb][i] = -INFINITY;
          }
        }
      }
      float mx = p[0][0];
#pragma unroll
      for (int kb = 0; kb < 4; ++kb) if (kb < nkb) {
#pragma unroll
        for (int i = 0; i < 16; ++i) mx = fmaxf(mx, p[kb][i]); }
      mx = fmaxf(mx, shx(mx, 32, lane));
      if (kt == 0 || __builtin_amdgcn_ballot_w64(mx > 8.f) != 0ull) {
        const float delta = (kt == 0) ? mx : fmaxf(mx, 0.f);
        const float alpha = (kt == 0) ? 0.f : __builtin_amdgcn_exp2f(-delta);
        mrun += delta; lrun *= alpha;
#pragma unroll
        for (int i = 0; i < 16; ++i) { o0[i] *= alpha; o1[i] *= alpha; }
#pragma unroll
        for (int kb = 0; kb < 4; ++kb)
#pragma unroll
          for (int i = 0; i < 16; ++i) p[kb][i] -= delta;
      }
      f32x2 ls2 = {0.f, 0.f};
#pragma unroll
      for (int kb = 0; kb < 4; ++kb) if (kb < nkb) {
#pragma unroll
        for (int i = 0; i < 16; ++i) p[kb][i] = __builtin_amdgcn_exp2f(p[kb][i]);
#pragma unroll
        for (int i = 0; i < 16; i += 2) { f32x2 t2; t2[0] = p[kb][i]; t2[1] = p[kb][i + 1]; ls2 += t2; }
#pragma unroll
        for (int s2 = 0; s2 < 2; ++s2) {
          u32x4 pw;
#pragma unroll
          for (int j = 0; j < 4; ++j) pw[j] = pk2(p[kb][8 * s2 + 2 * j], p[kb][8 * s2 + 2 * j + 1]);
          const bf16x8 pb = __builtin_bit_cast(bf16x8, pw);
          const int vfo = (32 * kb + 16 * s2 + 8 * hh) * 2;
          o0 = MFMA32(*(const bf16x8*)(Vb + r * 272 + vfo), pb, o0);
          o1 = MFMA32(*(const bf16x8*)(Vb + (32 + r) * 272 + vfo), pb, o1);
        }
      }
      lrun += ls2[0] + ls2[1];
    }
    if (kt + 1 < nt) AT_SWRITE(cur ^ 1);
    __syncthreads();
  }
#undef AT_GLOAD
#undef AT_SWRITE
  lrun += shx(lrun, 32, lane);
  const float inv = 1.f / lrun;
  const int b = bh >> 3, h = bh & 7;
  bf16_t* op = (bf16_t*)(ws + O_MIX) + (size_t)(b * 4096 + sq) * 1024 + 512 + h * 64;
#pragma unroll
  for (int g = 0; g < 4; ++g) {
    f32x4 a, c;
#pragma unroll
    for (int j = 0; j < 4; ++j) { a[j] = o0[4 * g + j] * inv; c[j] = o1[4 * g + j] * inv; }
    *(u32x2*)(op + 8 * g + 4 * hh) = pk4(a); *(u32x2*)(op + 32 + 8 * g + 4 * hh) = pk4(c);
  }
}

#define XB_TMO      128
#define XB_XCNT(j)  (256  + 64 * (j))
#define XB_XSUB(j)  (1280 + 64 * (j))
#define XB_XGEN(j)  (2304 + 64 * (j))
#define XB_TOP      3328
#define XB_TOPGEN   3392
#define XCD_BAR_WORDS 3456
#define XB_SPIN_CAP (1u << 18)
constexpr size_t O_BAR = 256 * 1024;
constexpr int LDS_XB = 143360;
DI unsigned xb_ld(unsigned* p)              { return __hip_atomic_load(p, __ATOMIC_RELAXED, __HIP_MEMORY_SCOPE_AGENT); }
DI unsigned xb_add(unsigned* p, unsigned v) { return __hip_atomic_fetch_add(p, v, __ATOMIC_RELAXED, __HIP_MEMORY_SCOPE_AGENT); }
DI unsigned xb_xcc_id() { return (unsigned)__builtin_amdgcn_s_getreg((3 << 11) | 20) & 0xFu; }
#define XB_SPIN(cond, bar) do { unsigned _sp = 0; while (cond) { __builtin_amdgcn_s_sleep(1); \
    if ((++_sp & 255u) == 0u) { if (xb_ld(&(bar)[XB_TMO])) break; if (_sp > XB_SPIN_CAP) { atomicAdd(&(bar)[XB_TMO], 1u); break; } } } } while (0)
DI void xcd_barrier_complete(unsigned* bar, unsigned x, unsigned G, unsigned& nloc, unsigned& nx) {
    unsigned sum, cnt, mine, sp = 0u;
    for (;;) {
        sum = 0u; cnt = 0u; mine = 0u;
#pragma unroll
        for (unsigned j = 0; j < 16; ++j) { const unsigned c = xb_ld(&bar[XB_XCNT(j)]); sum += c; cnt += (c > 0u) ? 1u : 0u; mine = (j == x) ? c : mine; }
        if (sum == G) break;
        __builtin_amdgcn_s_sleep(1);
        if ((++sp & 255u) == 0u) { if (xb_ld(&bar[XB_TMO])) break; if (sp > XB_SPIN_CAP) { atomicAdd(&bar[XB_TMO], 1u); break; } }
    }
    nloc = mine > 0u ? mine : 1u; nx = cnt > 0u ? cnt : 1u;
}
DI void xcd_barrier(unsigned char* ws, unsigned char* smem, int wv) {
    asm volatile("s_waitcnt vmcnt(0)" ::: "memory");
    __syncthreads();
    if (tid_(wv) == 0) {
        unsigned* bar = (unsigned*)(ws + O_BAR); const unsigned x = xb_xcc_id(); volatile LAS unsigned* st = (volatile LAS unsigned*)(smem + LDS_XB);
        __builtin_amdgcn_s_waitcnt(0);
        unsigned nloc = st[0], nx = st[1];
        if (nloc == 0u) { xcd_barrier_complete(bar, x, (unsigned)nblk_(), nloc, nx); st[0] = nloc; st[1] = nx; }
        const unsigned old = xb_add(&bar[XB_XSUB(x)], 1u);
        const unsigned gen = old / nloc;
        if (old + 1u == (gen + 1u) * nloc) {
            __builtin_amdgcn_fence(__ATOMIC_RELEASE, "agent");
            asm volatile("s_waitcnt vmcnt(0)" ::: "memory");
            const unsigned og = xb_add(&bar[XB_TOP], 1u);
            const unsigned tg = og / nx;
            if (og + 1u == (tg + 1u) * nx) xb_add(&bar[XB_TOPGEN], 1u);
            else XB_SPIN(xb_ld(&bar[XB_TOPGEN]) == tg, bar);
            __builtin_amdgcn_fence(__ATOMIC_ACQUIRE, "agent");
            xb_add(&bar[XB_XGEN(x)], 1u);
            asm volatile("s_waitcnt vmcnt(0)" ::: "memory");
        } else {
            XB_SPIN(xb_ld(&bar[XB_XGEN(x)]) == gen, bar);
            __builtin_amdgcn_fence(__ATOMIC_ACQUIRE, "agent");
            asm volatile("s_waitcnt vmcnt(0)" ::: "memory");
        }
    }
    __syncthreads();
}

__global__ void __launch_bounds__(512, 2) fwd_megakernel(Params P) {
  extern __shared__ __attribute__((aligned(16))) unsigned char smem[];
  cg::grid_group grid = cg::this_grid();
  unsigned char* ws = (unsigned char*)(GAS unsigned char*)P.ws;
  const int wv = __builtin_amdgcn_readfirstlane((int)(threadIdx.x >> 6));
  if (tid_(wv) == 0) { volatile LAS unsigned* st = (volatile LAS unsigned*)(smem + LDS_XB); st[0] = 0u; st[1] = 0u; (void)xb_add((unsigned*)(ws + O_BAR) + XB_XCNT(xb_xcc_id()), 1u); }
  { const int tid = tid_(wv); const float** tab = (const float**)(P.ws + O_TAB + (size_t)bid_() * 256);
    if (tid == 0) {
      tab[0] = P.in[0]; tab[1] = P.in[1]; tab[2] = P.in[2]; tab[3] = P.in[3]; tab[4] = P.in[4]; tab[5] = P.in[5]; tab[6] = P.in[6]; tab[7] = P.in[7]; tab[8] = P.in[8]; tab[9] = P.in[9]; tab[10] = P.in[10]; tab[11] = P.in[11]; tab[12] = P.in[12]; tab[13] = P.in[13]; tab[14] = P.in[14]; tab[15] = P.in[15]; tab[16] = P.in[16]; tab[17] = P.in[17]; tab[18] = P.in[18]; tab[19] = P.in[19]; tab[20] = P.in[20]; tab[21] = P.in[21]; tab[22] = P.in[22]; tab[23] = P.in[23]; tab[24] = P.in[24];
      tab[25] = P.out; }
    __threadfence(); __syncthreads(); }
#pragma unroll 1
  for (int L = 0; L < 2; ++L) {
    for (int rep = 0; rep < REP_P0; ++rep) { if (rep) xcd_barrier(ws, smem, wv);
    PH(0) phase0(P, L, smem, wv); }
    if (nblk_() == 0) grid.sync();
    xcd_barrier(ws, smem, wv);
#ifdef EXTRA_SYNC
    for (int e = 0; e < EXTRA_SYNC; ++e) xcd_barrier(ws, smem, wv);
#endif
    PH(1) { unsigned char* w = ws; LAUNDER_G(w); EpiProj E(P, w, L, smem);
      run_gemm(smem, (const bf16_t*)(w + O_AB), (const bf16_t*)(w + O_WIN), T, INP, 1024, E, wv); }
    xcd_barrier(ws, smem, wv);
#if defined(PROBE_P1)
    { unsigned char* w = ws; LAUNDER_G(w); EpiProj_<false> E(P, w, L, smem);
      run_gemm(smem, (const bf16_t*)(w + O_AB), (const bf16_t*)(w + O_WIN), T, INP, 1024, E, wv); }
#endif
    PH(2) { unsigned char* w = ws; LAUNDER_G(w); EpiQ E; E.ws = w; E.L = L; E.smem = smem;
      run_gemm(smem, (const bf16_t*)(w + O_CQ), (const bf16_t*)(w + O_WUQ), T, 768, 384, E, wv); }
    PH(3) { unsigned char* w = ws; LAUNDER_G(w); EpiKV E; E.ws = w; E.L = L; E.smem = smem;
      run_gemm(smem, (const bf16_t*)(w + O_CKV), (const bf16_t*)(w + O_WUKV), T, 1024, 256, E, wv); }
    for (int rep = 0; rep < REP_SMALL; ++rep) {
    PH(4) for (int it = bid_(); it < 512; it += nblk_()) sgu_item(P, L, it, smem, wv);
    PH(5) for (int it = bid_(); it < 512; it += nblk_()) hgrn_item<1>(P, L, it, smem, wv); }
    xcd_barrier(ws, smem, wv);
    for (int rep = 0; rep < REP_ATTN; ++rep) { if (rep) xcd_barrier(ws, smem, wv);
    PH(6) { int* cnt = (int*)(ws + O_CNT) + L + 2 * rep; int* slot = (int*)(smem + 143360 + 64); const int tid = tid_(wv);
      for (;;) {
        __syncthreads();
        if (tid == 0) *slot = atomicAdd(cnt, 1);
        __syncthreads();
        const int it = *slot;
        if (it >= 16 + 512) break;
        if (it < 16) hgrn_scan(P, it, wv);
        else { const int idx = it - 16; attn_unit(P, idx & 31, 15 - (idx >> 5), smem, wv); }
      } } }
    xcd_barrier(ws, smem, wv);
    for (int rep = 0; rep < REP_SMALL; ++rep)
    PH(7) for (int it = bid_(); it < 512; it += nblk_()) hgrn_item<3>(P, L, it, smem, wv);
    xcd_barrier(ws, smem, wv);
    PH(8) { unsigned char* w = ws; LAUNDER_G(w); EpiOut E(P, w, L, smem);
      run_gemm(smem, (const bf16_t*)(w + O_MIX), (const bf16_t*)(w + O_WOUT), T, 1024, 1024, E, wv); }
    PH(9) { unsigned char* w = ws; LAUNDER_G(w); EpiPle E; E.ws = w;
      run_gemm(smem, (const bf16_t*)(w + O_PB), (const bf16_t*)(w + O_WPP), T, 1024, 256, E, wv); }
    xcd_barrier(ws, smem, wv);
    PH(10) { unsigned char* w = ws; LAUNDER_G(w); EpiGU E; E.ws = w; E.L = L; E.smem = smem;
      run_gemm(smem, (const bf16_t*)(w + O_AB), (const bf16_t*)(w + O_WGU), T, NGU, 1024, E, wv); }
    xcd_barrier(ws, smem, wv);
#if defined(PROBE_GU) && PROBE_GU == 1
    { unsigned char* w = ws; LAUNDER_G(w); EpiNull E;
      run_gemm(smem, (const bf16_t*)(w + O_AB), (const bf16_t*)(w + O_WGU), T, 2 * DFF, 1024, E, wv); }
#elif defined(PROBE_GU) && PROBE_GU >= 2
    { unsigned char* w = ws; LAUNDER_G(w); EpiGU_<PROBE_GU - 1> E; E.ws = w; E.L = L; E.smem = smem;
      run_gemm(smem, (const bf16_t*)(w + O_AB), (const bf16_t*)(w + O_WGU), T, 2 * DFF, 1024, E, wv); }
#endif
    PH(11) { unsigned char* w = ws; LAUNDER_G(w); EpiDown E(P, w, L, smem);
      run_gemm(smem, (const bf16_t*)(w + O_ACT), (const bf16_t*)(w + O_WDN), T, 1024, DFF, E, wv); }
    xcd_barrier(ws, smem, wv);
  }
  { const float* st = (const float*)(ws + O_STAT + 2 * STAT_BYTES); const float* g = IN_(ws, I_LN2G) + 1024; const float* b = IN_(ws, I_LN2B) + 1024;
    float* outp = OUT_(ws);
    const int tid = tid_(wv); const int nth = nblk_() * 512;
    for (int i0 = bid_() * 512 + tid; i0 < T * 256; i0 += nth * 8) {
      const int c = (i0 & 255) * 4;
      const f32x4 gv = *(const GAS f32x4*)(g + c), bv = *(const GAS f32x4*)(b + c);
      f32x4 z[8]; float sm[8], sq[8];
#pragma unroll
      for (int k = 0; k < 8; ++k) { const int i = i0 + k * nth; const int row = (i < T * 256 ? i : i0) >> 8;
        z[k] = __builtin_nontemporal_load((const GAS f32x4*)(outp + (size_t)row * 1024 + c)); sm[k] = st[(size_t)row * 8]; sq[k] = st[(size_t)row * 8 + 1]; }
#pragma unroll
      for (int k = 0; k < 8; ++k) { const int i = i0 + k * nth;
        if (i < T * 256) { const float mean = sm[k] * (1.f / 1024.f), rstd = rsqrtf(fmaxf(sq[k] * (1.f / 1024.f) - mean * mean, 0.f) + LN_EPS);
          __builtin_nontemporal_store((z[k] - mean) * rstd * gv + bv, (GAS f32x4*)(outp + (size_t)(i >> 8) * 1024 + c)); } }
    } }
}

extern "C" void kernel_launch(void* const* d_in, const int* in_sizes, int n_in, void* d_out, int out_size, void* d_ws, size_t ws_size, hipStream_t stream) {
  static int grid_blocks = 0;
  if (grid_blocks == 0) {
    if (n_in != 25 || ws_size < WS_NEED) { fprintf(stderr, "kernel_launch: unexpected n_in %d or ws_size %zu\n", n_in, ws_size); grid_blocks = -1; return; }
    int dev = 0, cus = 0, per_cu = 0;
    hipGetDevice(&dev);
    hipDeviceGetAttribute(&cus, hipDeviceAttributeMultiprocessorCount, dev);
    if (hipFuncSetAttribute((const void*)fwd_megakernel, hipFuncAttributeMaxDynamicSharedMemorySize, LDS_BYTES) != hipSuccess) { fprintf(stderr, "kernel_launch: hipFuncSetAttribute failed\n"); }
    if (hipOccupancyMaxActiveBlocksPerMultiprocessor(&per_cu, (const void*)fwd_megakernel, 512, LDS_BYTES) != hipSuccess || per_cu < 1) { fprintf(stderr, "kernel_launch: occupancy query says %d\n", per_cu); per_cu = 1; }
    (void)hipGetLastError();
    grid_blocks = cus * 1;
    if (grid_blocks > 256) grid_blocks = 256;
  }
  if (grid_blocks < 0) return;
  if (hipMemsetAsync((char*)d_ws + O_BAR, 0, XCD_BAR_WORDS * 4, stream) != hipSuccess) { fprintf(stderr, "kernel_launch: memset failed\n"); return; }
  Params p{};
  for (int i = 0; i < 25; ++i) p.in[i] = (const float*)d_in[i];
  p.out = (float*)d_out; p.ws = (unsigned char*)d_ws;
  void* args[] = {&p};
  hipError_t e = hipLaunchCooperativeKernel((const void*)fwd_megakernel, dim3(grid_blocks), dim3(512), args, LDS_BYTES, stream);
  if (e != hipSuccess) fprintf(stderr, "cooperative launch failed: %s (grid %d)\n", hipGetErrorString(e), grid_blocks);
}
```

```cpp
#include <hip/hip_runtime.h>
#include <hip/hip_cooperative_groups.h>
#include <cstdio>
#include <cstdint>
namespace cg = cooperative_groups;
__device__ __forceinline__ int tid_(int wv);
namespace pg8 {
#define PG8_LAS __attribute__((address_space(3)))
typedef unsigned short bf16_t;
typedef short bf16x8 __attribute__((ext_vector_type(8)));
typedef float f32x4 __attribute__((ext_vector_type(4)));
typedef unsigned u32x4 __attribute__((ext_vector_type(4)));
constexpr int BM = 256, BK = 64, HALF = 128, HTB = HALF * BK * 2  , STAGE_BYTES = 8 * HTB, NXCD = 8, WGM = 8;

__host__ __device__ __forceinline__ int lds_byte(int r, int c) { const int st = (r >> 4) * 2 + (c >> 5), rr = r & 15, cc = c & 31, ob = rr * 64 + cc * 2; return st * 1024 + (ob ^ (((ob >> 9) & 1) << 5)); }
__host__ __device__ __forceinline__ void stage_rc(int b, int& R, int& C) { const int st = b / 1024, sb = b % 1024, swz = sb ^ (((sb >> 9) & 1) << 5); R = (st >> 1) * 16 + swz / 64; C = (st & 1) * 32 + (swz % 64) / 2; }
__host__ __device__ __forceinline__ int perm32(int rho) { const int n = rho >> 4, i = rho & 15; return 8 * (i >> 2) + 4 * n + (i & 3); }

struct Unit { int pm, pn; };
struct Gemm { const bf16_t* A; const bf16_t* Bt; int M, N, K; };

struct StaticOrder {
    int nM, nN, nwg, G, c;
    __host__ __device__ void init(int M, int N, int G_, int c_) { nM = M / BM; nN = N / BM; nwg = nM * nN; G = G_; c = c_; }
    __host__ __device__ bool next(int i, Unit& u) const {
        const long L = (long)i * G + c; if (L >= nwg) return false;
        int wgid = (int)L; { const int q = nwg / NXCD, r = nwg % NXCD, xcd = wgid % NXCD, off = wgid / NXCD; wgid = (xcd < r ? xcd * (q + 1) : r * (q + 1) + (xcd - r) * q) + off; }
        const int nig = WGM * nN, gid = wgid / nig, fm = gid * WGM, gsz = (nM - fm) < WGM ? (nM - fm) : WGM;
        u.pm = fm + ((wgid % nig) % gsz); u.pn = (wgid % nig) / gsz; return true;
    }
    __device__ __forceinline__ void a_ready(const Unit&) const {}
    __device__ __forceinline__ void done(const Unit&) const {}
};

template <class Epi, class Sched>
__device__ __forceinline__ void gemm_phase(PG8_LAS unsigned char* lds, const Gemm g, const Sched& S, const Epi& E, int wv) {
    const int tid = tid_(wv), wid = __builtin_amdgcn_readfirstlane(tid >> 6), lane = tid & 63, wr = wid >> 2, wc = wid & 3, fr = lane & 15, fq = lane >> 4;
    const int K = g.K, nt = K / BK;
    unsigned voffA[2], voffB[2];
#pragma unroll
    for (int i = 0; i < 2; ++i) { int R, C; stage_rc(tid * 16 + i * 8192, R, C); const int Rb = Epi::PERM ? ((R & ~31) + perm32(R & 31)) : R;
        voffA[i] = (unsigned)(R * K + C) * 2u; voffB[i] = (unsigned)(Rb * K + C) * 2u; }
    const size_t kstep = (size_t)(BK * 2);
    const size_t hstep = (size_t)HALF * K * 2;
    const size_t tstep = 2 * hstep;
    const unsigned ldsw = (unsigned)wid * 1024u;
    const int aoff = lds_byte(wr * 64 + fr, fq * 8), boff = lds_byte(wc * 32 + fr, fq * 8);
#define PG8_SA(b, h) (((b) * 2 + (h)) * HTB)
#define PG8_SB(b, h) ((4 + (b) * 2 + (h)) * HTB)
#define PG8_STAGE(bufoff, gbase, voff) do { _Pragma("unroll") for (int _i = 0; _i < 2; ++_i) \
        __builtin_amdgcn_global_load_lds((const unsigned*)((const char*)(gbase) + (voff)[_i]), (PG8_LAS unsigned*)(lds + (bufoff) + ldsw + _i * 8192), 16, 0, 0); } while (0)
#define PG8_LDA(dst, b, h) do { _Pragma("unroll") for (int m = 0; m < 4; ++m) _Pragma("unroll") for (int k = 0; k < 2; ++k) dst[m][k] = *(const PG8_LAS bf16x8*)(lds + PG8_SA(b, h) + aoff + m * 2048 + k * 1024); } while (0)
#define PG8_LDB(dst, b, h) do { _Pragma("unroll") for (int n = 0; n < 2; ++n) _Pragma("unroll") for (int k = 0; k < 2; ++k) dst[n][k] = *(const PG8_LAS bf16x8*)(lds + PG8_SB(b, h) + boff + n * 2048 + k * 1024); } while (0)
#define PG8_MMA(ai, bj, At, Bt) do { __builtin_amdgcn_s_setprio(1); _Pragma("unroll") for (int m = 0; m < 4; ++m) _Pragma("unroll") for (int n = 0; n < 2; ++n) _Pragma("unroll") for (int k = 0; k < 2; ++k) \
        acc[ai][bj][m][n] = __builtin_amdgcn_mfma_f32_16x16x32_bf16(Bt[n][k], At[m][k], acc[ai][bj][m][n], 0, 0, 0); __builtin_amdgcn_s_setprio(0); } while (0)
#define PG8_WAIT_V(n) asm volatile("s_waitcnt vmcnt(" #n ")" ::: "memory")
#define PG8_WAIT_L(n) asm volatile("s_waitcnt lgkmcnt(" #n ")" ::: "memory")
#define PG8_BAR __builtin_amdgcn_s_barrier()
#define PG8_SCHED __builtin_amdgcn_sched_barrier(0)
    Unit cur, nxt; int ui = 0;
    if (!S.next(0, cur)) return;
    f32x4 acc[2][2][4][2];
#pragma unroll
    for (int a = 0; a < 2; ++a)
#pragma unroll
        for (int b = 0; b < 2; ++b)
#pragma unroll
            for (int m = 0; m < 4; ++m)
#pragma unroll
                for (int n = 0; n < 2; ++n) acc[a][b][m][n] = (f32x4){0.f, 0.f, 0.f, 0.f};
    bf16x8 At[4][2], B0[2][2], B1[2][2];
    float pf[6] = {0.f, 0.f, 0.f, 0.f, 0.f, 0.f};
    const char* cA = (const char*)g.A + (size_t)cur.pm * tstep; const char* cB = (const char*)g.Bt + (size_t)cur.pn * tstep;
    S.a_ready(cur);
    PG8_STAGE(PG8_SB(0, 0), cB, voffB); PG8_STAGE(PG8_SA(0, 0), cA, voffA); PG8_STAGE(PG8_SB(0, 1), cB + hstep, voffB); PG8_STAGE(PG8_SA(0, 1), cA + hstep, voffA);
    if (wr == 1) PG8_BAR;
    PG8_WAIT_V(4); PG8_BAR;
    PG8_STAGE(PG8_SB(1, 0), cB + kstep, voffB); PG8_STAGE(PG8_SA(1, 0), cA + kstep, voffA); PG8_STAGE(PG8_SB(1, 1), cB + hstep + kstep, voffB);
    PG8_WAIT_V(6); PG8_BAR;
    for (;;) {
        const bool has_next = S.next(ui + 1, nxt);
        const char* nA = has_next ? (const char*)g.A + (size_t)nxt.pm * tstep : cA; const char* nB = has_next ? (const char*)g.Bt + (size_t)nxt.pn * tstep : cB;
        for (int t = 0; t < nt; t += 2) {
            const bool last = (t == nt - 2);
            const char* a1 = cA + (size_t)(t + 1) * kstep;
            const char* a2 = last ? nA : cA + (size_t)(t + 2) * kstep; const char* b2 = last ? nB : cB + (size_t)(t + 2) * kstep;
            const char* a3 = a2 + kstep; const char* b3 = b2 + kstep;
            if (last && has_next) S.a_ready(nxt);
            if (last) E.prefetch(cur, wr, wc, tid_(wv) & 63, pf);
            PG8_LDB(B0, 0, 0); PG8_SCHED; PG8_LDA(At, 0, 0); PG8_STAGE(PG8_SA(1, 1), a1 + hstep, voffA);
            PG8_WAIT_L(8); PG8_BAR; PG8_WAIT_L(0); PG8_MMA(0, 0, At, B0); PG8_BAR; PG8_SCHED;
            PG8_LDB(B1, 0, 1); PG8_STAGE(PG8_SB(0, 0), b2, voffB);
            PG8_BAR; PG8_WAIT_L(0); PG8_MMA(0, 1, At, B1); PG8_BAR;
            PG8_LDA(At, 0, 1); PG8_STAGE(PG8_SA(0, 0), a2, voffA);
            PG8_BAR; PG8_WAIT_L(0); PG8_MMA(1, 0, At, B0); PG8_BAR; PG8_SCHED;
            PG8_STAGE(PG8_SB(0, 1), b2 + hstep, voffB);
            PG8_WAIT_V(6); PG8_BAR; PG8_MMA(1, 1, At, B1); PG8_BAR;
            PG8_LDB(B0, 1, 0); PG8_SCHED; PG8_LDA(At, 1, 0); PG8_STAGE(PG8_SA(0, 1), a2 + hstep, voffA);
            PG8_WAIT_L(8); PG8_BAR; PG8_WAIT_L(0); PG8_MMA(0, 0, At, B0); PG8_BAR; PG8_SCHED;
            PG8_LDB(B1, 1, 1); PG8_STAGE(PG8_SB(1, 0), b3, voffB);
            PG8_BAR; PG8_WAIT_L(0); PG8_MMA(0, 1, At, B1); PG8_BAR;
            PG8_LDA(At, 1, 1); PG8_STAGE(PG8_SA(1, 0), a3, voffA);
            PG8_BAR; PG8_WAIT_L(0); PG8_MMA(1, 0, At, B0); PG8_BAR; PG8_SCHED;
            PG8_STAGE(PG8_SB(1, 1), b3 + hstep, voffB);
            PG8_WAIT_V(6); PG8_BAR; PG8_MMA(1, 1, At, B1); PG8_BAR;
        }
        if constexpr (!Epi::AFTER_DRAIN) { E(acc, cur, wr, wc, fr, fq, pf); S.done(cur); }
        if (!has_next) break;
#pragma unroll
        for (int a = 0; a < 2; ++a)
#pragma unroll
            for (int b = 0; b < 2; ++b)
#pragma unroll
                for (int m = 0; m < 4; ++m)
#pragma unroll
                    for (int n = 0; n < 2; ++n) acc[a][b][m][n] = (f32x4){0.f, 0.f, 0.f, 0.f};
        cur = nxt; cA = nA; cB = nB; ++ui;
    }
    PG8_WAIT_V(0);
    if (wr == 0) PG8_BAR;
    PG8_BAR;
    if constexpr (Epi::AFTER_DRAIN) { E.fused(acc, cur, wr, wc, fr, fq, lds, wid, lane); S.done(cur); }
#undef PG8_SA
#undef PG8_SB
#undef PG8_STAGE
#undef PG8_LDA
#undef PG8_LDB
#undef PG8_MMA
#undef PG8_WAIT_V
#undef PG8_WAIT_L
#undef PG8_BAR
#undef PG8_SCHED
}
}


#define LAS __attribute__((address_space(3)))
typedef unsigned short bf16_t;
typedef short bf16x8 __attribute__((ext_vector_type(8)));
typedef float f32x4 __attribute__((ext_vector_type(4)));
typedef float f32x16 __attribute__((ext_vector_type(16)));
typedef float f32x2 __attribute__((ext_vector_type(2)));
typedef __bf16 bf16x2_t __attribute__((ext_vector_type(2)));
typedef unsigned u32x2 __attribute__((ext_vector_type(2)));
typedef unsigned u32x4 __attribute__((ext_vector_type(4)));
#define DI __device__ __forceinline__
#define MFMA32(a, b, c) __builtin_amdgcn_mfma_f32_32x32x16_bf16((a), (b), (c), 0, 0, 0)

DI unsigned pk2(float lo, float hi) { f32x2 v = {lo, hi}; bf16x2_t b = __builtin_convertvector(v, bf16x2_t); return __builtin_bit_cast(unsigned, b); }
DI unsigned short f2bf(float x) { return (unsigned short)(pk2(x, 0.f) & 0xffffu); }
DI float bf2f(unsigned short b) { return __uint_as_float(((unsigned)b) << 16); }
DI u32x2 pk4(f32x4 v) { u32x2 r; r[0] = pk2(v[0], v[1]); r[1] = pk2(v[2], v[3]); return r; }
DI f32x4 unpk4(u32x2 u) { f32x4 r; r[0] = __uint_as_float(u[0] << 16); r[1] = __uint_as_float(u[0] & 0xffff0000u); r[2] = __uint_as_float(u[1] << 16); r[3] = __uint_as_float(u[1] & 0xffff0000u); return r; }
DI int crow(int reg, int h) { return (reg & 3) + 8 * (reg >> 2) + 4 * h; }
DI float sigmoidf_(float x) { return __builtin_amdgcn_rcpf(1.f + __builtin_amdgcn_exp2f(x * -1.4426950408889634f)); }
DI float siluf_(float x) { return x * __builtin_amdgcn_rcpf(1.f + __builtin_amdgcn_exp2f(x * -1.4426950408889634f)); }
DI float geluf_(float v) {
  const float av = fabsf(v), t = __builtin_amdgcn_rcpf(av * 0.2316418882f + 1.0f);
  float q = t * 0.5307027145f + (-0.7265760135f); q = q * t + 0.7107068705f; q = q * t + (-0.142248368f); q = q * t + 0.127414796f; q = q * t;
  const float e = __builtin_amdgcn_exp2f((v * v) * (-0.72134752044f));
  const float m = v * (q * e);
  return v < 0.f ? m : v - m;
}
#define xor_sum_fq(v) xor_sum_fq_((v), (fq << 4) | fr)

constexpr int T = 16384, SEQ = 4096;
constexpr int INC = 2208, INP = 2304, DFF = 2816, NGU = 6656;
constexpr float LN_EPS = 1e-5f, RMS_EPS = 1e-6f, ALPHA = 1.4142135623730951f;
constexpr float QSCALE = 0.10206207261596575f * 1.4426950408889634f;
constexpr size_t MiB = 1u << 20;
constexpr size_t O_CNT = 0, O_CSIN = 64 * 1024, O_BWIN = 80 * 1024, O_CSGU = 128 * 1024, O_BWGU = 192 * 1024;
constexpr size_t O_TAB = 512 * 1024;
constexpr size_t O_STAT = 1 * MiB, STAT_BYTES = (size_t)T * 8 * 4;
constexpr size_t O_ROPE = 3 * MiB;
constexpr size_t O_WIN = 5 * MiB, O_WUQ = O_WIN + (size_t)INP * 1024 * 2, O_WUKV = O_WUQ + 768 * 384 * 2, O_WOUT = O_WUKV + 1024 * 256 * 2,
    O_WGU = O_WOUT + 1024 * 1024 * 2, O_WDN = O_WGU + (size_t)NGU * 1024 * 2, O_WPP = O_WDN + (size_t)1024 * DFF * 2, O_WS = O_WPP + 1024 * 256 * 2, O_WEND = O_WS + 4 * 128 * 128 * 2;
static_assert(O_WEND <= 32 * MiB, "weights");
constexpr size_t O_AB = 32 * MiB, O_PB = 64 * MiB, O_MIX = 72 * MiB;
constexpr size_t O_LF = 104 * MiB, O_QH = 120 * MiB, O_KH = 128 * MiB, O_VH = 136 * MiB, O_GS = 144 * MiB, O_GU = 152 * MiB, O_GV = 160 * MiB, O_CQ = 168 * MiB, O_CKV = 180 * MiB,
    O_CKR = 188 * MiB, O_QF = 190 * MiB, O_KF = 214 * MiB, O_VT = 238 * MiB;
constexpr size_t O_PLE = 104 * MiB, O_ACT = 136 * MiB;
constexpr size_t O_CKVT = 32 * MiB, O_SP = 48 * MiB, O_DEC = 56 * MiB, O_EREF = 56 * MiB + 512 * 1024;
constexpr size_t WS_NEED = 256 * MiB;
constexpr int LDS_BYTES = 147456;

#ifndef REP_ATTN
#define REP_ATTN 1
#endif
#ifndef REP_SMALL
#define REP_SMALL 1
#endif
#ifndef REP_P0
#define REP_P0 1
#endif
#ifndef PHMASK
#define PHMASK 0xffff
#endif
#define PH(k) if ((PHMASK >> (k)) & 1)
struct Params { const float* in[25]; float* out; unsigned char* ws; };
enum { I_X = 0, I_P, I_POS, I_LNING, I_LNINB, I_WIN, I_LBL, I_HNG, I_SLNG, I_SLNB, I_SWS, I_SBS, I_QNG, I_WUQ, I_KVNG, I_WUKV, I_WOUT, I_LN1G, I_LN1B, I_WGU, I_WDN, I_PWG, I_PWP, I_LN2G, I_LN2B };

DI int bid_() { int b = blockIdx.x; asm volatile("" : "+s"(b)); return b; }
DI int nblk_() { int b = gridDim.x; asm volatile("" : "+s"(b)); return b; }
DI int tid_(int wv) { int l; asm volatile("v_mbcnt_lo_u32_b32 %0, -1, 0\n\tv_mbcnt_hi_u32_b32 %0, -1, %0" : "=v"(l)); return (wv << 6) | l; }
DI float shx(float v, int mask, int lane) { return __int_as_float(__builtin_amdgcn_ds_bpermute((lane ^ mask) << 2, __float_as_int(v))); }
#define GAS __attribute__((address_space(1)))
#define LAUNDER_G(p) do { GAS unsigned char* g_ = (GAS unsigned char*)(p); asm volatile("" : "+s"(g_)); (p) = (unsigned char*)g_; } while (0)
DI const float* in_ptr_(unsigned char* w, int k) { const float* p = ((const float* const*)(w + O_TAB + (size_t)bid_() * 256))[k];

#if defined(__HIP_DEVICE_COMPILE__)
  __builtin_assume(!__builtin_amdgcn_is_shared((const void*)p)); __builtin_assume(!__builtin_amdgcn_is_private((const void*)p));
#endif
  return p; }
#define IN_(w, k) in_ptr_((w), (k))
#define OUT_(w) ((float*)in_ptr_((w), 25))
DI float xor_sum_fq_(float v, int lane) { v += shx(v, 16, lane); v += shx(v, 32, lane); return v; }
DI void ln_stats(const float* st, float& mean, float& rstd) {
  const float s = st[0], q = st[1]; mean = s * (1.f / 1024.f); const float var = q * (1.f / 1024.f) - mean * mean; rstd = rsqrtf(fmaxf(var, 0.f) + LN_EPS);
}

DI void conv64(const float* __restrict__ W, int ldw, int k0, int klen, int c0, int nvalid, const float* __restrict__ g, const float* __restrict__ bv,
               bf16_t* __restrict__ dst, int ldd, float* cs_out, float* bw_out, unsigned char* smem, int wv) {
  bf16_t* tile = (bf16_t*)smem;
  float* red = (float*)(smem + 20480);
  const int tid = tid_(wv), c = tid & 63, kq = wv;
  const bool valid = (c0 + c) < nvalid;
  float cs = 0.f, bw = 0.f;
  float w[16], gg[16], bb[16];
#define CV_LOAD(kt_) do { _Pragma("unroll") for (int i = 0; i < 16; ++i) { const int kx = k0 + (kt_) + kq * 16 + i; \
    w[i] = valid ? __builtin_nontemporal_load((const GAS float*)W + (size_t)kx * ldw + c0 + c) : 0.f; gg[i] = g ? ((const GAS float*)g)[kx] : 1.f; bb[i] = bv ? ((const GAS float*)bv)[kx] : 0.f; } } while (0)
  CV_LOAD(0);
  for (int kt = 0; kt < klen; kt += 128) {
#pragma unroll
    for (int i = 0; i < 16; ++i) {
      const unsigned short b = f2bf(w[i] * gg[i]);
      cs += bf2f(b); bw += bb[i] * w[i];
      tile[c * 136 + kq * 16 + i] = b;
    }
    if (kt + 128 < klen) CV_LOAD(kt + 128);
    __syncthreads();
#pragma unroll
    for (int pp = 0; pp < 2; ++pp) { const int p = tid + 512 * pp, cc = p >> 4, kk = p & 15;
      const u32x4 v = *(const u32x4*)(tile + cc * 136 + kk * 8);
      *(u32x4*)(dst + (size_t)cc * ldd + k0 + kt + kk * 8) = v; }
    __syncthreads();
  }
#undef CV_LOAD
  if (cs_out) {
    red[kq * 64 + c] = cs; red[512 + kq * 64 + c] = bw; __syncthreads();
    if (tid < 64) { float a = 0.f, b = 0.f;
#pragma unroll
      for (int q = 0; q < 8; ++q) { a += red[q * 64 + tid]; b += red[512 + q * 64 + tid]; }
      cs_out[tid] = a; bw_out[tid] = b; }
    __syncthreads();
  }
}

DI void phase0(const Params& P, int L, unsigned char* smem, int wv) {
  unsigned char* ws = P.ws; LAUNDER_G(ws);
  const int tid = tid_(wv), lane = tid & 63, wid = wv;
  const int nblk = nblk_();
  for (int it = bid_(); it < 256; it += nblk) {
    if (it < 36) {
      const float* g = L == 0 ? IN_(ws, I_LNING) : IN_(ws, I_LN2G) + (size_t)(L - 1) * 1024;
      const float* b = L == 0 ? IN_(ws, I_LNINB) : IN_(ws, I_LN2B) + (size_t)(L - 1) * 1024;
      conv64(IN_(ws, I_WIN) + (size_t)L * 1024 * INC, INC, 0, 1024, it * 64, INC, g, b, (bf16_t*)(ws + O_WIN) + (size_t)it * 64 * 1024, 1024,
             (float*)(ws + O_CSIN) + it * 64, (float*)(ws + O_BWIN) + it * 64, smem, wv);
    } else if (it < 48) {
      const int j = it - 36;
      conv64(IN_(ws, I_WUQ) + (size_t)L * 384 * 768, 768, 0, 384, j * 64, 768, IN_(ws, I_QNG) + L * 384, nullptr, (bf16_t*)(ws + O_WUQ) + (size_t)j * 64 * 384, 384, nullptr, nullptr, smem, wv);
    } else if (it < 64) {
      const int j = it - 48;
      conv64(IN_(ws, I_WUKV) + (size_t)L * 256 * 1024, 1024, 0, 256, j * 64, 1024, IN_(ws, I_KVNG) + L * 256, nullptr, (bf16_t*)(ws + O_WUKV) + (size_t)j * 64 * 256, 256, nullptr, nullptr, smem, wv);
    } else if (it < 80) {
      const int j = it - 64;
      conv64(IN_(ws, I_WOUT) + (size_t)L * 1024 * 1024, 1024, 0, 1024, j * 64, 1024, nullptr, nullptr, (bf16_t*)(ws + O_WOUT) + (size_t)j * 64 * 1024, 1024, nullptr, nullptr, smem, wv);
    } else if (it < 168) {
      const int c0 = (it - 80) * 64;
      int drow;
      if (c0 < DFF) drow = 256 * (c0 >> 7) + (c0 & 127); else { const int c1 = c0 - DFF; drow = 256 * (c1 >> 7) + 128 + (c1 & 127); }
      conv64(IN_(ws, I_WGU) + (size_t)L * 1024 * 2 * DFF, 2 * DFF, 0, 1024, c0, 2 * DFF, IN_(ws, I_LN1G) + L * 1024, IN_(ws, I_LN1B) + L * 1024, (bf16_t*)(ws + O_WGU) + (size_t)drow * 1024, 1024,
             (float*)(ws + O_CSGU) + drow, (float*)(ws + O_BWGU) + drow, smem, wv);
    } else if (it < 184) {
      const int j = it - 168; const int drow = 2 * DFF + j * 64;
      conv64(IN_(ws, I_PWG) + (size_t)L * 1024 * 1024, 1024, 0, 1024, j * 64, 1024, IN_(ws, I_LN1G) + L * 1024, IN_(ws, I_LN1B) + L * 1024, (bf16_t*)(ws + O_WGU) + (size_t)drow * 1024, 1024,
             (float*)(ws + O_CSGU) + drow, (float*)(ws + O_BWGU) + drow, smem, wv);
    } else if (it < 232) {
      const int idx = it - 184, j = idx / 3, kc = idx - 3 * j;
      conv64(IN_(ws, I_WDN) + (size_t)L * DFF * 1024, 1024, kc * 1024, kc < 2 ? 1024 : 768, j * 64, 1024, nullptr, nullptr, (bf16_t*)(ws + O_WDN) + (size_t)j * 64 * DFF, DFF, nullptr, nullptr, smem, wv);
    } else if (it < 248) {
      const int j = it - 232;
      conv64(IN_(ws, I_PWP) + (size_t)L * 256 * 1024, 1024, 0, 256, j * 64, 1024, nullptr, nullptr, (bf16_t*)(ws + O_WPP) + (size_t)j * 64 * 256, 256, nullptr, nullptr, smem, wv);
    } else {
      const int j = it - 248;
      const float* src = IN_(ws, I_SWS) + (size_t)L * 65536; bf16_t* dst = (bf16_t*)(ws + O_WS);
      for (int e = j * 8192 + tid; e < (j + 1) * 8192; e += 512) { const int s = e & 127, t = (e >> 7) & 127; dst[e] = (s <= t) ? f2bf(((const GAS float*)src)[e]) : (unsigned short)0; }
    }
  }
  {
    const float* src = IN_(ws, I_P) + (size_t)L * T * 256; bf16_t* dst = (bf16_t*)(ws + O_PB);
    for (size_t i = (size_t)bid_() * 512 + tid; i < (size_t)T * 256 / 8; i += (size_t)nblk * 512) {
      const f32x4 a = __builtin_nontemporal_load((const GAS f32x4*)(src + i * 8)), b = __builtin_nontemporal_load((const GAS f32x4*)(src + i * 8 + 4));
      u32x4 o; o[0] = pk2(a[0], a[1]); o[1] = pk2(a[2], a[3]); o[2] = pk2(b[0], b[1]); o[3] = pk2(b[2], b[3]);
      *(u32x4*)(dst + i * 8) = o;
    }
  }
  if (L == 0) {
    if (bid_() == 0 && tid < 16) ((int*)(ws + O_CNT))[tid] = 0;
    const float* x = IN_(ws, I_X); bf16_t* xb = (bf16_t*)(ws + O_AB); float* st = (float*)(ws + O_STAT);
    {
      const int rstep = nblk * 8; int row = bid_() * 8 + wid;
      f32x4 vc[4], vn[4];
#pragma unroll
      for (int j = 0; j < 4; ++j) { vc[j] = __builtin_nontemporal_load((const GAS f32x4*)(x + (size_t)(row < T ? row : 0) * 1024 + j * 256 + lane * 4)); vn[j] = vc[j]; }
      for (; row < T; row += rstep) {
        const int rn = row + rstep < T ? row + rstep : row;
#pragma unroll
        for (int j = 0; j < 4; ++j) vn[j] = __builtin_nontemporal_load((const GAS f32x4*)(x + (size_t)rn * 1024 + j * 256 + lane * 4));
        float s = 0.f, q = 0.f;
#pragma unroll
        for (int j = 0; j < 4; ++j) {
          const f32x4 v = vc[j];
          s += v[0] + v[1] + v[2] + v[3]; q += v[0] * v[0] + v[1] * v[1] + v[2] * v[2] + v[3] * v[3];
          *(u32x2*)(xb + (size_t)row * 1024 + j * 256 + lane * 4) = pk4(v);
        }
#pragma unroll
        for (int o = 32; o >= 1; o >>= 1) { s += shx(s, o, lane); q += shx(q, o, lane); }
        if (lane < 24) { float v = 0.f; if (lane == 0) v = s; if (lane == 1) v = q; st[(size_t)(lane >> 3) * T * 8 + (size_t)row * 8 + (lane & 7)] = v; }
#pragma unroll
        for (int j = 0; j < 4; ++j) vc[j] = vn[j];
      }
    }
    const int* pos = (const int*)IN_(ws, I_POS); float* rope = (float*)(ws + O_ROPE);
    for (int i = bid_() * 512 + tid; i < T * 16; i += nblk * 512) {
      const int t = i >> 4, j = i & 15;
      const float inv = powf(10000.0f, -(float)j * (1.f / 16.f));
      const float ang = (float)((const GAS int*)pos)[t] * inv;
      double rv = (double)ang * 0.15915494309189535; rv -= rint(rv);
      const float rr = (float)(rv * 6.283185307179586);
      rope[t * 32 + j] = cosf(rr); rope[t * 32 + 16 + j] = sinf(rr);
    }
  }
}
typedef f32x4 AccT[2][2][4][2];
#define ROWSTATS(statp, off, base_row) float mean_[8], rstd_[8]; _Pragma("unroll") for (int q_ = 0; q_ < 8; ++q_) { const int row_ = (base_row) + (q_ >> 2) * 128 + (q_ & 3) * 16; \
    ln_stats((statp) + (size_t)row_ * 8 + (off), mean_[q_], rstd_[q_]); }


constexpr int LDS_EPI = 131072;
typedef float PfT[6];
DI void epi_prefetch(const float* stat, int off, const float* colA, const float* colB, const pg8::Unit& u, int wr, int wc, int lane, PfT& pf) {
  const int ra = u.pm * 256 + wr * 64 + ((lane >> 4) & 3) * 16 + (lane & 15);
  const f32x2 a = *(const GAS f32x2*)(stat + (size_t)ra * 8 + off), b = *(const GAS f32x2*)(stat + (size_t)(ra + 128) * 8 + off);
  const int col = u.pn * 256 + (lane >> 5) * 128 + wc * 32 + (lane & 31);
  pf[0] = a[0]; pf[1] = a[1]; pf[2] = b[0]; pf[3] = b[1]; pf[4] = ((const GAS float*)colA)[col]; pf[5] = ((const GAS float*)colB)[col];
}
#define EPI_STAGE(smem_, pf_, wid_, lane_) unsigned char* lw_ = (smem_) + LDS_EPI + (wid_) * 1536; { \
    const float m0_ = (pf_)[0] * (1.f / 1024.f), m1_ = (pf_)[2] * (1.f / 1024.f); \
    f32x2 w0_, w1_; w0_[0] = m0_; w0_[1] = rsqrtf(fmaxf((pf_)[1] * (1.f / 1024.f) - m0_ * m0_, 0.f) + LN_EPS); w1_[0] = m1_; w1_[1] = rsqrtf(fmaxf((pf_)[3] * (1.f / 1024.f) - m1_ * m1_, 0.f) + LN_EPS); \
    *(f32x2*)(lw_ + (lane_) * 8) = w0_; *(f32x2*)(lw_ + ((lane_) + 64) * 8) = w1_; *(float*)(lw_ + 1024 + (lane_) * 4) = (pf_)[4]; *(float*)(lw_ + 1280 + (lane_) * 4) = (pf_)[5]; } \
  float mean_[8], rstd_[8]; _Pragma("unroll") for (int q_ = 0; q_ < 8; ++q_) { const f32x2 t_ = *(const f32x2*)(lw_ + ((q_ >> 2) * 64 + (q_ & 3) * 16 + fr) * 8); mean_[q_] = t_[0]; rstd_[q_] = t_[1]; }
#define EPI_COLA(bj_, n_) (*(const f32x4*)(lw_ + 1024 + ((bj_) * 32 + 16 * (n_) + 4 * fq) * 4))
#define EPI_COLB(bj_, n_) (*(const f32x4*)(lw_ + 1280 + ((bj_) * 32 + 16 * (n_) + 4 * fq) * 4))
#define EPI_COLA_P(bj_, n_) (*(const f32x4*)(lw_ + 1024 + ((bj_) * 32 + 8 * fq + 4 * (n_)) * 4))
#define EPI_COLB_P(bj_, n_) (*(const f32x4*)(lw_ + 1280 + ((bj_) * 32 + 8 * fq + 4 * (n_)) * 4))
template <bool ATOM> struct EpiProj_ {
  static constexpr bool PERM = true, AFTER_DRAIN = false;
  const Params& P; unsigned char* ws; int layer; unsigned char* smem;
  DI EpiProj_(const Params& P_, unsigned char* w, int L, unsigned char* sm) : P(P_), ws(w), layer(L), smem(sm) {}
  template <int ACT, int SM, int bj> DI void half_bf16(const AccT& acc, int pm, int wr, int wc, int fr, int fq, int cbase, size_t dsto, int ld, int coff, int slot, const float (&mean_)[8], const float (&rstd_)[8], unsigned char* lw_) const {
    const int cb = cbase + wc * 32 + 8 * fq;
    bf16_t* dst = (bf16_t*)(ws + dsto); float* stat = (float*)(ws + O_STAT + (size_t)layer * STAT_BYTES);
    f32x4 csv[2], bwv[2];
#pragma unroll
    for (int n = 0; n < 2; ++n) { csv[n] = EPI_COLA_P(bj, n); bwv[n] = EPI_COLB_P(bj, n); }
#pragma unroll
    for (int ai = 0; ai < 2; ++ai)
#pragma unroll
      for (int m = 0; m < 4; ++m) {
        const int row = pm * 256 + ai * 128 + wr * 64 + m * 16 + fr;
        const float mean = mean_[ai * 4 + m], rstd = rstd_[ai * 4 + m];
        float s1 = 0.f, s2 = 0.f;
        u32x4 w_;
#pragma unroll
        for (int n = 0; n < 2; ++n) {
          f32x4 v = (acc[ai][bj][m][n] - csv[n] * mean) * rstd + bwv[n];
#pragma unroll
          for (int j = 0; j < 4; ++j) { if (ACT == 1) v[j] = siluf_(v[j]); if (ACT == 2) v[j] = geluf_(v[j]); }
          if (SM) { s1 += v[0] + v[1] + v[2] + v[3]; s2 += v[0] * v[0] + v[1] * v[1] + v[2] * v[2] + v[3] * v[3]; }
          const u32x2 h_ = pk4(v); w_[2 * n] = h_[0]; w_[2 * n + 1] = h_[1];
        }
        *(u32x4*)(dst + (size_t)row * ld + (cb - coff)) = w_;
        if (SM) {
          s2 = xor_sum_fq(s2); if (SM == 2) s1 = xor_sum_fq(s1);
          if (ATOM && fq == 0) { if (SM == 2) { atomicAdd(stat + (size_t)row * 8 + slot, s1); atomicAdd(stat + (size_t)row * 8 + slot + 1, s2); } else atomicAdd(stat + (size_t)row * 8 + slot, s2); }
        }
      }
  }
  template <int bj> DI void half_forget(const AccT& acc, int pm, int wr, int wc, int fr, int fq, int cbase, const float (&mean_)[8], const float (&rstd_)[8], unsigned char* lw_) const {
    const int cb = cbase + wc * 32 + 8 * fq;
    const float* lbl = IN_(ws, I_LBL); float* LF = (float*)(ws + O_LF); bf16_t* KH = (bf16_t*)(ws + O_KH);
    f32x4 csv[2], bwv[2], lb[2];
#pragma unroll
    for (int n = 0; n < 2; ++n) {
      csv[n] = EPI_COLA_P(bj, n); bwv[n] = EPI_COLB_P(bj, n);
      const f32x4 l0 = *(const f32x4*)(lbl + (cb + 4 * n - 256)), l1 = *(const f32x4*)(lbl + 256 + (cb + 4 * n - 256));
#pragma unroll
      for (int j = 0; j < 4; ++j) lb[n][j] = layer == 0 ? 0.f : 1.f / (1.f + expf(l0[j] - l1[j]));
    }
#pragma unroll
    for (int ai = 0; ai < 2; ++ai)
#pragma unroll
      for (int m = 0; m < 4; ++m) {
        const int row = pm * 256 + ai * 128 + wr * 64 + m * 16 + fr;
        const float mean = mean_[ai * 4 + m], rstd = rstd_[ai * 4 + m];
        u32x4 w_;
#pragma unroll
        for (int n = 0; n < 2; ++n) {
          const f32x4 v = (acc[ai][bj][m][n] - csv[n] * mean) * rstd + bwv[n];
          f32x4 lf, kk;
#pragma unroll
          for (int j = 0; j < 4; ++j) { const float sg = sigmoidf_(v[j]); const float f = lb[n][j] + (1.f - lb[n][j]) * sg; lf[j] = __logf(f); kk[j] = 1.f - f; }
          *(f32x4*)(LF + (size_t)row * 256 + (cb + 4 * n - 256)) = lf;
          const u32x2 h_ = pk4(kk); w_[2 * n] = h_[0]; w_[2 * n + 1] = h_[1];
        }
        *(u32x4*)(KH + (size_t)row * 256 + (cb - 256)) = w_;
      }
  }
  template <int bj> DI void half_ckr(const AccT& acc, int pm, int wr, int wc, int fr, int fq, int cbase, const float (&mean_)[8], const float (&rstd_)[8], unsigned char* lw_) const {
    if (wc != 0) return;
    const float* rope = (const float*)(ws + O_ROPE); bf16_t* KFp = (bf16_t*)(ws + O_KF);
    const int lane = (fq << 4) | fr;
    const bool isx1 = fq < 2;
    const int ri = 8 * (fq & 1);
    f32x4 csv[2], bwv[2];
#pragma unroll
    for (int n = 0; n < 2; ++n) { csv[n] = EPI_COLA_P(bj, n); bwv[n] = EPI_COLB_P(bj, n); }
    const int row0 = pm * 256 + wr * 64 + fr;
    f32x4 cc[2], sc[2], cn[2], sn[2];
#pragma unroll
    for (int n = 0; n < 2; ++n) { cc[n] = *(const f32x4*)(rope + (size_t)row0 * 32 + ri + 4 * n); sc[n] = *(const f32x4*)(rope + (size_t)row0 * 32 + 16 + ri + 4 * n); cn[n] = cc[n]; sn[n] = sc[n]; }
#pragma unroll
    for (int q = 0; q < 8; ++q) {
      const int ai = q >> 2, m = q & 3, row = row0 + ai * 128 + m * 16;
      if (q < 7) { const int rown = row0 + ((q + 1) >> 2) * 128 + ((q + 1) & 3) * 16;
#pragma unroll
        for (int n = 0; n < 2; ++n) { cn[n] = *(const f32x4*)(rope + (size_t)rown * 32 + ri + 4 * n); sn[n] = *(const f32x4*)(rope + (size_t)rown * 32 + 16 + ri + 4 * n); } }
      const float mean = mean_[q], rstd = rstd_[q];
      u32x4 w_;
#pragma unroll
      for (int n = 0; n < 2; ++n) {
        const f32x4 own = (acc[ai][bj][m][n] - csv[n] * mean) * rstd + bwv[n];
        f32x4 oth;
#pragma unroll
        for (int j = 0; j < 4; ++j) oth[j] = shx(own[j], 32, lane);
        const f32x4 res = isx1 ? own * cc[n] - oth * sc[n] : own * cc[n] + oth * sc[n];
        const u32x2 h_ = pk4(res); w_[2 * n] = h_[0]; w_[2 * n + 1] = h_[1];
      }
      bf16_t* kd = KFp + ((size_t)((row >> 12) * 8) * 4096 + (row & 4095)) * 96 + 64 + 8 * fq;
#pragma unroll
      for (int hd = 0; hd < 8; ++hd) *(u32x4*)(kd + (size_t)hd * 4096 * 96) = w_;
#pragma unroll
      for (int n = 0; n < 2; ++n) { cc[n] = cn[n]; sc[n] = sn[n]; }
    }
  }
  template <int bj> DI void do_half(const AccT& acc, const pg8::Unit& u, int wr, int wc, int fr, int fq, const float (&mean_)[8], const float (&rstd_)[8], unsigned char* lw_) const {
          const int gid = u.pn * 2 + bj, cbase = gid * 128;
      switch (gid) {
        case 0: case 1:   half_bf16<1, 0, bj>(acc, u.pm, wr, wc, fr, fq, cbase, O_QH, 256, 0, 0, mean_, rstd_, lw_); break;
        case 2: case 3:   half_forget<bj>(acc, u.pm, wr, wc, fr, fq, cbase, mean_, rstd_, lw_); break;
        case 4: case 5:   half_bf16<0, 0, bj>(acc, u.pm, wr, wc, fr, fq, cbase, O_VH, 256, 512, 0, mean_, rstd_, lw_); break;
        case 6: case 7:   half_bf16<1, 0, bj>(acc, u.pm, wr, wc, fr, fq, cbase, O_GS, 256, 768, 0, mean_, rstd_, lw_); break;
        case 8: case 9:   half_bf16<2, 0, bj>(acc, u.pm, wr, wc, fr, fq, cbase, O_GU, 256, 1024, 0, mean_, rstd_, lw_); break;
        case 10: case 11: half_bf16<2, 2, bj>(acc, u.pm, wr, wc, fr, fq, cbase, O_GV, 256, 1280, 6, mean_, rstd_, lw_); break;
        case 12: case 13: case 14: half_bf16<0, 1, bj>(acc, u.pm, wr, wc, fr, fq, cbase, O_CQ, 384, 1536, 4, mean_, rstd_, lw_); break;
        case 15: case 16: half_bf16<0, 1, bj>(acc, u.pm, wr, wc, fr, fq, cbase, O_CKV, 256, 1920, 5, mean_, rstd_, lw_); break;
        default:          half_ckr<bj>(acc, u.pm, wr, wc, fr, fq, cbase, mean_, rstd_, lw_); break;
      }
  }
  DI void prefetch(const pg8::Unit& u, int wr, int wc, int lane, PfT& pf) const {
    epi_prefetch((const float*)(ws + O_STAT + (size_t)layer * STAT_BYTES), 0, (const float*)(ws + O_CSIN), (const float*)(ws + O_BWIN), u, wr, wc, lane, pf);
  }
  DI void operator()(const AccT& acc, const pg8::Unit& u, int wr, int wc, int fr, int fq, PfT& pf) const {
    const int l_ = tid_(wr * 4 + wc) & 63; fr = l_ & 15; fq = l_ >> 4;
    EPI_STAGE(smem, pf, wr * 4 + wc, l_)
    do_half<0>(acc, u, wr, wc, fr, fq, mean_, rstd_, lw_); do_half<1>(acc, u, wr, wc, fr, fq, mean_, rstd_, lw_);
  }
};
typedef EpiProj_<true> EpiProj;
struct EpiQ {
  static constexpr bool PERM = true, AFTER_DRAIN = false;
  unsigned char* ws; int L; unsigned char* smem;
  DI void prefetch(const pg8::Unit& u, int wr, int wc, int lane, PfT& pf) const {
    const float* stat = (const float*)(ws + O_STAT + (size_t)L * STAT_BYTES);
    const int ra = u.pm * 256 + wr * 64 + ((lane >> 4) & 3) * 16 + (lane & 15);
    pf[0] = ((const GAS float*)stat)[(size_t)ra * 8 + 4]; pf[1] = ((const GAS float*)stat)[(size_t)(ra + 128) * 8 + 4];
  }
  DI void operator()(const AccT& acc, const pg8::Unit& u, int wr, int wc, int fr, int fq, PfT& pf) const {
    const int l_ = tid_(wr * 4 + wc) & 63; fr = l_ & 15; fq = l_ >> 4;
    unsigned char* lw_ = smem + LDS_EPI + (wr * 4 + wc) * 1536;
    *(float*)(lw_ + l_ * 4) = rsqrtf(pf[0] * (1.f / 384.f) + RMS_EPS) * QSCALE; *(float*)(lw_ + (l_ + 64) * 4) = rsqrtf(pf[1] * (1.f / 384.f) + RMS_EPS) * QSCALE;
    float rs_[8];
#pragma unroll
    for (int q_ = 0; q_ < 8; ++q_) rs_[q_] = *(const float*)(lw_ + ((q_ >> 2) * 64 + (q_ & 3) * 16 + fr) * 4);
    half<0>(acc, u, wr, wc, fr, fq, rs_); half<1>(acc, u, wr, wc, fr, fq, rs_);
  }
  template <int bj> DI void half(const AccT& acc, const pg8::Unit& u, int wr, int wc, int fr, int fq, const float (&rs_)[8]) const {
    const float* stat = (const float*)(ws + O_STAT + (size_t)L * STAT_BYTES); const float* rope = (const float*)(ws + O_ROPE);
    const int b = u.pm >> 4, s0 = (u.pm & 15) * 256;
    {
      const int g32 = 8 * u.pn + 4 * bj + wc, head = g32 / 3, part = g32 - 3 * head;
      bf16_t* base = (bf16_t*)(ws + O_QF) + (size_t)((b * 8 + head) * 4096 + s0) * 96 + part * 32;
      if (part < 2) {
#pragma unroll
        for (int ai = 0; ai < 2; ++ai)
#pragma unroll
          for (int m = 0; m < 4; ++m) {
            const int rl = ai * 128 + wr * 64 + m * 16 + fr; const float rs = rs_[ai * 4 + m];
            const u32x2 lo_ = pk4(acc[ai][bj][m][0] * rs), hi_ = pk4(acc[ai][bj][m][1] * rs); u32x4 w_ = {lo_[0], lo_[1], hi_[0], hi_[1]};
            *(u32x4*)(base + rl * 96 + 8 * fq) = w_;
          }
      } else {
        const int lane = (fq << 4) | fr; const bool isx1 = fq < 2; const int ri = 8 * (fq & 1);
        const int row0 = u.pm * 256 + wr * 64 + fr;
        f32x4 cc[2], sc[2], cn[2], sn[2];
#pragma unroll
        for (int n = 0; n < 2; ++n) { cc[n] = *(const f32x4*)(rope + row0 * 32 + ri + 4 * n); sc[n] = *(const f32x4*)(rope + row0 * 32 + 16 + ri + 4 * n); cn[n] = cc[n]; sn[n] = sc[n]; }
#pragma unroll
        for (int q = 0; q < 8; ++q) {
          const int ai = q >> 2, m = q & 3, rl = ai * 128 + wr * 64 + m * 16 + fr;
          if (q < 7) { const int rown = row0 + ((q + 1) >> 2) * 128 + ((q + 1) & 3) * 16;
#pragma unroll
            for (int n = 0; n < 2; ++n) { cn[n] = *(const f32x4*)(rope + rown * 32 + ri + 4 * n); sn[n] = *(const f32x4*)(rope + rown * 32 + 16 + ri + 4 * n); } }
          const float rs = rs_[q];
          u32x4 w_;
#pragma unroll
          for (int n = 0; n < 2; ++n) {
            const f32x4 own = acc[ai][bj][m][n] * rs;
            f32x4 oth;
#pragma unroll
            for (int jj = 0; jj < 4; ++jj) oth[jj] = shx(own[jj], 32, lane);
            const f32x4 res = isx1 ? own * cc[n] - oth * sc[n] : own * cc[n] + oth * sc[n];
            const u32x2 h_ = pk4(res); w_[2 * n] = h_[0]; w_[2 * n + 1] = h_[1];
          }
          *(u32x4*)(base + rl * 96 + 8 * fq) = w_;
#pragma unroll
          for (int n = 0; n < 2; ++n) { cc[n] = cn[n]; sc[n] = sn[n]; }
        }
      }
    }
  }
};
struct EpiKV {
  static constexpr bool PERM = true, AFTER_DRAIN = false;
  unsigned char* ws; int L; unsigned char* smem;
  DI void prefetch(const pg8::Unit& u, int wr, int wc, int lane, PfT& pf) const {
    const float* stat = (const float*)(ws + O_STAT + (size_t)L * STAT_BYTES);
    const int ra = u.pm * 256 + wr * 64 + ((lane >> 4) & 3) * 16 + (lane & 15);
    pf[0] = ((const GAS float*)stat)[(size_t)ra * 8 + 5]; pf[1] = ((const GAS float*)stat)[(size_t)(ra + 128) * 8 + 5];
  }
  DI void operator()(const AccT& acc, const pg8::Unit& u, int wr, int wc, int fr, int fq, PfT& pf) const {
    const int l_ = tid_(wr * 4 + wc) & 63; fr = l_ & 15; fq = l_ >> 4;
    unsigned char* lw_ = smem + LDS_EPI + (wr * 4 + wc) * 1536;
    *(float*)(lw_ + l_ * 4) = rsqrtf(pf[0] * (1.f / 256.f) + RMS_EPS); *(float*)(lw_ + (l_ + 64) * 4) = rsqrtf(pf[1] * (1.f / 256.f) + RMS_EPS);
    float rs_[8];
#pragma unroll
    for (int q_ = 0; q_ < 8; ++q_) rs_[q_] = *(const float*)(lw_ + ((q_ >> 2) * 64 + (q_ & 3) * 16 + fr) * 4);
    half<0>(acc, u, wr, wc, fr, fq, rs_); half<1>(acc, u, wr, wc, fr, fq, rs_);
  }
  template <int bj> DI void half(const AccT& acc, const pg8::Unit& u, int wr, int wc, int fr, int fq, const float (&rs_)[8]) const {
    const float* stat = (const float*)(ws + O_STAT + (size_t)L * STAT_BYTES);
    const int b = u.pm >> 4, s0 = (u.pm & 15) * 256, head = 2 * u.pn + bj;
    bf16_t* base = wc < 2 ? (bf16_t*)(ws + O_KF) + (size_t)((b * 8 + head) * 4096 + s0) * 96 + 32 * wc : (bf16_t*)(ws + O_VT) + (size_t)((b * 8 + head) * 4096 + s0) * 64 + 32 * (wc - 2);
    const int ld = wc < 2 ? 96 : 64;
#pragma unroll
    for (int ai = 0; ai < 2; ++ai)
#pragma unroll
      for (int m = 0; m < 4; ++m) {
        const int rl = ai * 128 + wr * 64 + m * 16 + fr;
        const float rs = rs_[ai * 4 + m];
        bf16_t* dst = base + rl * ld + 8 * fq;
        { const u32x2 lo_ = pk4(acc[ai][bj][m][0] * rs), hi_ = pk4(acc[ai][bj][m][1] * rs); u32x4 w_ = {lo_[0], lo_[1], hi_[0], hi_[1]}; *(u32x4*)dst = w_; }
      }
  }
};
struct EpiOut {
  static constexpr bool PERM = true, AFTER_DRAIN = false;
  const Params& P; unsigned char* ws; int L; unsigned char* smem;
  DI EpiOut(const Params& P_, unsigned char* w, int L_, unsigned char* sm) : P(P_), ws(w), L(L_), smem(sm) {}
  DI void prefetch(const pg8::Unit& u, int wr, int wc, int lane, PfT& pf) const {
    const float* g = L == 0 ? IN_(ws, I_LNING) : IN_(ws, I_LN2G) + (size_t)(L - 1) * 1024; const float* b = L == 0 ? IN_(ws, I_LNINB) : IN_(ws, I_LN2B) + (size_t)(L - 1) * 1024;
    epi_prefetch((const float*)(ws + O_STAT + (size_t)L * STAT_BYTES), 0, g, b, u, wr, wc, lane, pf);
  }
  DI void operator()(const AccT& acc, const pg8::Unit& u, int wr, int wc, int fr, int fq, PfT& pf) const {
    const int l_ = tid_(wr * 4 + wc) & 63; fr = l_ & 15; fq = l_ >> 4;
    const float* src = L == 0 ? IN_(ws, I_X) : OUT_(ws); float* out = OUT_(ws); float* stat = (float*)(ws + O_STAT + (size_t)L * STAT_BYTES);
    bf16_t* YB = (bf16_t*)(ws + O_AB);
    const int row0 = u.pm * 256 + wr * 64 + fr;
    EPI_STAGE(smem, pf, wr * 4 + wc, l_)
#pragma unroll
    for (int bj = 0; bj < 2; ++bj) {
      const int c0 = u.pn * 256 + 128 * bj + wc * 32 + 8 * fq;
      const f32x4 g0 = EPI_COLA_P(bj, 0), g1 = EPI_COLA_P(bj, 1), b0 = EPI_COLB_P(bj, 0), b1 = EPI_COLB_P(bj, 1);
      f32x4 xc0 = __builtin_nontemporal_load((const GAS f32x4*)(src + (size_t)row0 * 1024 + c0)), xc1 = __builtin_nontemporal_load((const GAS f32x4*)(src + (size_t)row0 * 1024 + c0 + 4)), xn0 = xc0, xn1 = xc1;
#pragma unroll
      for (int q = 0; q < 8; ++q) {
        const int ai = q >> 2, m = q & 3, row = row0 + ai * 128 + m * 16;
        if (q < 7) { const int rown = row0 + ((q + 1) >> 2) * 128 + ((q + 1) & 3) * 16; xn0 = __builtin_nontemporal_load((const GAS f32x4*)(src + (size_t)rown * 1024 + c0)); xn1 = __builtin_nontemporal_load((const GAS f32x4*)(src + (size_t)rown * 1024 + c0 + 4)); }
        const float mean = mean_[q], rstd = rstd_[q];
        const size_t o = (size_t)row * 1024 + c0;
        const f32x4 y0 = ((xc0 - mean) * rstd * g0 + b0) * ALPHA + acc[ai][bj][m][0], y1 = ((xc1 - mean) * rstd * g1 + b1) * ALPHA + acc[ai][bj][m][1];
        __builtin_nontemporal_store(y0, (GAS f32x4*)(out + o)); __builtin_nontemporal_store(y1, (GAS f32x4*)(out + o + 4)); { const u32x2 lo_ = pk4(y0), hi_ = pk4(y1); u32x4 w_ = {lo_[0], lo_[1], hi_[0], hi_[1]}; *(u32x4*)(YB + o) = w_; }
        float s1 = y0[0] + y0[1] + y0[2] + y0[3] + y1[0] + y1[1] + y1[2] + y1[3];
        float s2 = y0[0] * y0[0] + y0[1] * y0[1] + y0[2] * y0[2] + y0[3] * y0[3] + y1[0] * y1[0] + y1[1] * y1[1] + y1[2] * y1[2] + y1[3] * y1[3];
        s1 = xor_sum_fq(s1); s2 = xor_sum_fq(s2);
        if (fq == 0) { atomicAdd(stat + (size_t)row * 8 + 2, s1); atomicAdd(stat + (size_t)row * 8 + 3, s2); }
        xc0 = xn0; xc1 = xn1;
      }
    }
  }
};
struct EpiPle {
  static constexpr bool PERM = true, AFTER_DRAIN = false;
  unsigned char* ws;
  DI void prefetch(const pg8::Unit&, int, int, int, PfT&) const {}
  DI void operator()(const AccT& acc, const pg8::Unit& u, int wr, int wc, int fr, int fq, PfT& pf) const {
    { const int l_ = tid_(wr * 4 + wc) & 63; fr = l_ & 15; fq = l_ >> 4; }
    const int c0 = u.pn * 256 + wc * 32 + 8 * fq; bf16_t* PLE = (bf16_t*)(ws + O_PLE);
#pragma unroll
    for (int ai = 0; ai < 2; ++ai)
#pragma unroll
      for (int m = 0; m < 4; ++m) {
        const int row = u.pm * 256 + ai * 128 + wr * 64 + m * 16 + fr;
#pragma unroll
        for (int bj = 0; bj < 2; ++bj) { const u32x2 lo_ = pk4(acc[ai][bj][m][0]), hi_ = pk4(acc[ai][bj][m][1]); u32x4 w_ = {lo_[0], lo_[1], hi_[0], hi_[1]};
          *(u32x4*)(PLE + (size_t)row * 1024 + c0 + 128 * bj) = w_; }
      }
  }
};
template <int MODE> struct EpiGU_ {
  static constexpr bool PERM = true, AFTER_DRAIN = false;
  unsigned char* ws; int L; unsigned char* smem;
  DI void prefetch(const pg8::Unit& u, int wr, int wc, int lane, PfT& pf) const {
    epi_prefetch((const float*)(ws + O_STAT + (size_t)L * STAT_BYTES), 2, (const float*)(ws + O_CSGU), (const float*)(ws + O_BWGU), u, wr, wc, lane, pf);
  }
  DI void operator()(const AccT& acc, const pg8::Unit& u, int wr, int wc, int fr, int fq, PfT& pf) const {
    const int l_ = tid_(wr * 4 + wc) & 63; fr = l_ & 15; fq = l_ >> 4;
    const float* stat = (const float*)(ws + O_STAT + (size_t)L * STAT_BYTES); const float* cs = (const float*)(ws + O_CSGU); const float* bw = (const float*)(ws + O_BWGU);
    bf16_t* ACT = (bf16_t*)(ws + O_ACT); bf16_t* PLE = (bf16_t*)(ws + O_PLE);
    const int c0 = u.pn * 256 + wc * 32 + 8 * fq;
    const int row0 = u.pm * 256 + wr * 64 + fr;
    EPI_STAGE(smem, pf, wr * 4 + wc, l_)
    f32x4 csv[2][2], bwv[2][2];
#pragma unroll
    for (int bj = 0; bj < 2; ++bj)
#pragma unroll
      for (int n = 0; n < 2; ++n) { csv[bj][n] = EPI_COLA_P(bj, n); bwv[bj][n] = EPI_COLB_P(bj, n); }
    if (u.pn < 22) {
#pragma unroll
      for (int q = 0; q < 8; ++q) {
        const int ai = q >> 2, m = q & 3, row = row0 + ai * 128 + m * 16;
        const float mean = mean_[q], rstd = rstd_[q];
        u32x4 w_;
#pragma unroll
        for (int n = 0; n < 2; ++n) {
          const f32x4 gt = (acc[ai][0][m][n] - csv[0][n] * mean) * rstd + bwv[0][n];
          const f32x4 up = (acc[ai][1][m][n] - csv[1][n] * mean) * rstd + bwv[1][n];
          f32x4 a;
#pragma unroll
          for (int j = 0; j < 4; ++j) a[j] = siluf_(gt[j]) * up[j];
          const u32x2 h_ = pk4(a); w_[2 * n] = h_[0]; w_[2 * n + 1] = h_[1];
        }
        if (MODE == 0) *(u32x4*)(ACT + (size_t)row * DFF + u.pn * 128 + wc * 32 + 8 * fq) = w_;
        else *(u32x4*)((bf16_t*)(ws + O_MIX) + (size_t)row * 1024 + ((u.pn * 128 + wc * 32 + 8 * fq) & 1023)) = w_;
      }
    } else {
      u32x2 pc[4], pn_[4];
#pragma unroll
      for (int t = 0; t < 4; ++t) pc[t] = *(const u32x2*)(PLE + (size_t)row0 * 1024 + (c0 - 2 * DFF) + 128 * (t >> 1) + 4 * (t & 1));
#pragma unroll
      for (int q = 0; q < 8; ++q) {
        const int ai = q >> 2, m = q & 3, row = row0 + ai * 128 + m * 16;
        if (q < 7) { const int rown = row0 + ((q + 1) >> 2) * 128 + ((q + 1) & 3) * 16;
#pragma unroll
          for (int t = 0; t < 4; ++t) pn_[t] = *(const u32x2*)(PLE + (size_t)rown * 1024 + (c0 - 2 * DFF) + 128 * (t >> 1) + 4 * (t & 1)); }
        const float mean = mean_[q], rstd = rstd_[q];
#pragma unroll
        for (int t = 0; t < 4; ++t) {
          const int bj = t >> 1, n = t & 1;
          const f32x4 v = (acc[ai][bj][m][n] - csv[bj][n] * mean) * rstd + bwv[bj][n];
          const f32x4 pl = unpk4(pc[t]);
          f32x4 o;
#pragma unroll
          for (int j = 0; j < 4; ++j) o[j] = sigmoidf_(v[j]) * pl[j];
          *(u32x2*)(PLE + (size_t)row * 1024 + (c0 - 2 * DFF) + 128 * bj + 4 * n) = pk4(o);
        }
#pragma unroll
        for (int t = 0; t < 4; ++t) pc[t] = pn_[t];
      }
    }
  }
};
typedef EpiGU_<0> EpiGU;
struct EpiDown {
  static constexpr bool PERM = true, AFTER_DRAIN = false;
  const Params& P; unsigned char* ws; int L; unsigned char* smem;
  DI EpiDown(const Params& P_, unsigned char* w, int L_, unsigned char* sm) : P(P_), ws(w), L(L_), smem(sm) {}
  DI void prefetch(const pg8::Unit& u, int wr, int wc, int lane, PfT& pf) const {
    epi_prefetch((const float*)(ws + O_STAT + (size_t)L * STAT_BYTES), 2, IN_(ws, I_LN1G) + (size_t)L * 1024, IN_(ws, I_LN1B) + (size_t)L * 1024, u, wr, wc, lane, pf);
  }
  DI void operator()(const AccT& acc, const pg8::Unit& u, int wr, int wc, int fr, int fq, PfT& pf) const {
    const int l_ = tid_(wr * 4 + wc) & 63; fr = l_ & 15; fq = l_ >> 4;
    float* out = OUT_(ws); const float* stat = (const float*)(ws + O_STAT + (size_t)L * STAT_BYTES); float* stat_next = (float*)(ws + O_STAT + (size_t)(L + 1) * STAT_BYTES);
    const bf16_t* PLE = (const bf16_t*)(ws + O_PLE); bf16_t* ZB = (bf16_t*)(ws + O_AB);
    const int row0 = u.pm * 256 + wr * 64 + fr;
    EPI_STAGE(smem, pf, wr * 4 + wc, l_)
#pragma unroll
    for (int bj = 0; bj < 2; ++bj) {
      const int c0 = u.pn * 256 + 128 * bj + wc * 32 + 8 * fq;
      const f32x4 g0 = EPI_COLA_P(bj, 0), g1 = EPI_COLA_P(bj, 1), b0 = EPI_COLB_P(bj, 0), b1 = EPI_COLB_P(bj, 1);
      f32x4 yc0 = __builtin_nontemporal_load((const GAS f32x4*)(out + (size_t)row0 * 1024 + c0)), yc1 = __builtin_nontemporal_load((const GAS f32x4*)(out + (size_t)row0 * 1024 + c0 + 4)), yn0 = yc0, yn1 = yc1;
      u32x2 pc0 = __builtin_nontemporal_load((const GAS u32x2*)(PLE + (size_t)row0 * 1024 + c0)), pc1 = __builtin_nontemporal_load((const GAS u32x2*)(PLE + (size_t)row0 * 1024 + c0 + 4)), pn0 = pc0, pn1 = pc1;
#pragma unroll
      for (int q = 0; q < 8; ++q) {
        const int ai = q >> 2, m = q & 3, row = row0 + ai * 128 + m * 16;
        if (q < 7) { const size_t on = (size_t)(row0 + ((q + 1) >> 2) * 128 + ((q + 1) & 3) * 16) * 1024 + c0;
          yn0 = __builtin_nontemporal_load((const GAS f32x4*)(out + on)); yn1 = __builtin_nontemporal_load((const GAS f32x4*)(out + on + 4)); pn0 = __builtin_nontemporal_load((const GAS u32x2*)(PLE + on)); pn1 = __builtin_nontemporal_load((const GAS u32x2*)(PLE + on + 4)); }
        const float mean = mean_[q], rstd = rstd_[q];
        const size_t o = (size_t)row * 1024 + c0;
        const f32x4 z0 = ((yc0 - mean) * rstd * g0 + b0) * ALPHA + acc[ai][bj][m][0] + unpk4(pc0), z1 = ((yc1 - mean) * rstd * g1 + b1) * ALPHA + acc[ai][bj][m][1] + unpk4(pc1);
        __builtin_nontemporal_store(z0, (GAS f32x4*)(out + o)); __builtin_nontemporal_store(z1, (GAS f32x4*)(out + o + 4)); if (L == 0) { const u32x2 lo_ = pk4(z0), hi_ = pk4(z1); u32x4 w_ = {lo_[0], lo_[1], hi_[0], hi_[1]}; *(u32x4*)(ZB + o) = w_; }
        float s1 = z0[0] + z0[1] + z0[2] + z0[3] + z1[0] + z1[1] + z1[2] + z1[3];
        float s2 = z0[0] * z0[0] + z0[1] * z0[1] + z0[2] * z0[2] + z0[3] * z0[3] + z1[0] * z1[0] + z1[1] * z1[1] + z1[2] * z1[2] + z1[3] * z1[3];
        s1 = xor_sum_fq(s1); s2 = xor_sum_fq(s2);
        if (fq == 0) { atomicAdd(stat_next + (size_t)row * 8 + 0, s1); atomicAdd(stat_next + (size_t)row * 8 + 1, s2); }
        yc0 = yn0; yc1 = yn1; pc0 = pn0; pc1 = pn1;
      }
    }
  }
};
struct EpiNull { static constexpr bool PERM = false, AFTER_DRAIN = false;
  DI void prefetch(const pg8::Unit&, int, int, int, PfT&) const {}
  DI void operator()(const AccT& acc, const pg8::Unit& u, int wr, int wc, int fr, int fq, PfT& pf) const { f32x4 t = {0.f, 0.f, 0.f, 0.f};
#pragma unroll
    for (int a = 0; a < 2; ++a)
#pragma unroll
      for (int b = 0; b < 2; ++b)
#pragma unroll
        for (int m = 0; m < 4; ++m)
#pragma unroll
          for (int n = 0; n < 2; ++n) t += acc[a][b][m][n];
    if (t[0] + t[1] + t[2] + t[3] == 1.2345e-30f) __builtin_amdgcn_s_sleep(1); } };
template <class Epi> DI void run_gemm(unsigned char* smem, const bf16_t* A, const bf16_t* Bt, int M, int N, int K, const Epi& E, int wv) {
  pg8::StaticOrder S; S.init(M, N, nblk_(), (int)bid_());
  int Kx = K; asm volatile("" : "+s"(Kx));
  pg8::Gemm g; g.A = A; g.Bt = Bt; g.M = M; g.N = N; g.K = Kx;
  __syncthreads();
  pg8::gemm_phase<Epi, pg8::StaticOrder>((LAS unsigned char*)smem, g, S, E, wv);
  __syncthreads();
}
DI void sgu_item(const Params& P, int L, int item, unsigned char* smem, int wv) {
  unsigned char* ws = P.ws; LAUNDER_G(ws);
  const int tid = tid_(wv), lane = tid & 63, wid = wv, r = lane & 31, hh = lane >> 5;
  const int chunk = item >> 2, grp = item & 3, tok0 = chunk * 128;
  const bf16_t* GV = (const bf16_t*)(ws + O_GV); const bf16_t* GU = (const bf16_t*)(ws + O_GU); bf16_t* MIX = (bf16_t*)(ws + O_MIX);
  const float* stat = (const float*)(ws + O_STAT + (size_t)L * STAT_BYTES);
  bf16_t* sVl = (bf16_t*)smem;
  __syncthreads();
  const int tb = wid >> 1, cb = wid & 1, nks = 2 * (tb + 1);
  const bf16_t* Wg = (const bf16_t*)(ws + O_WS) + (size_t)grp * 128 * 128 + (size_t)(32 * tb + r) * 128 + 8 * hh;
  bf16x8 a[8];
#pragma unroll
  for (int ks = 0; ks < 8; ++ks) { if (ks < nks) a[ks] = *(const bf16x8*)(Wg + 16 * ks); else a[ks] = (bf16x8){0, 0, 0, 0, 0, 0, 0, 0}; }
  float uu[16];
#pragma unroll
  for (int i = 0; i < 16; ++i) uu[i] = bf2f(GU[(size_t)(tok0 + 32 * tb + crow(i, hh)) * 256 + grp * 64 + 32 * cb + r]);
  { const int s = tid >> 2, part = tid & 3;
    const float sm = stat[(size_t)(tok0 + s) * 8 + 6], sq = stat[(size_t)(tok0 + s) * 8 + 7];
    const float mean = sm * (1.f / 256.f), rstd = rsqrtf(fmaxf(sq * (1.f / 256.f) - mean * mean, 0.f) + LN_EPS);
    const bf16_t* gp = GV + (size_t)(tok0 + s) * 256 + grp * 64 + part * 16;
    const u32x4 g0 = *(const u32x4*)gp, g1 = *(const u32x4*)(gp + 8);
    const float* lgp = IN_(ws, I_SLNG) + L * 256 + grp * 64 + part * 16; const float* lbp = IN_(ws, I_SLNB) + L * 256 + grp * 64 + part * 16;
#pragma unroll
    for (int i = 0; i < 8; ++i) {
      const unsigned w = i < 4 ? g0[i & 3] : g1[i & 3];
      const float v0 = __uint_as_float(w << 16), v1 = __uint_as_float(w & 0xffff0000u);
      sVl[(part * 16 + 2 * i) * 136 + s] = f2bf((v0 - mean) * rstd * lgp[2 * i] + lbp[2 * i]);
      sVl[(part * 16 + 2 * i + 1) * 136 + s] = f2bf((v1 - mean) * rstd * lgp[2 * i + 1] + lbp[2 * i + 1]);
    } }
  __syncthreads();
  const float* bs = IN_(ws, I_SBS) + (size_t)L * 512 + grp * 128 + 32 * tb;
  f32x16 c; for (int i = 0; i < 16; ++i) c[i] = 0.f;
#pragma unroll
  for (int ks = 0; ks < 8; ++ks) if (ks < nks) c = MFMA32(a[ks], *(const bf16x8*)(sVl + (32 * cb + r) * 136 + 16 * ks + 8 * hh), c);
#pragma unroll
  for (int i = 0; i < 16; ++i) {
    const int t = crow(i, hh);
    MIX[(size_t)(tok0 + 32 * tb + t) * 1024 + 256 + grp * 64 + 32 * cb + r] = f2bf(uu[i] * (c[i] + bs[t]));
  }
  __syncthreads();
}

template <int STEP> DI void hgrn_item(const Params& P, int L, int pair, unsigned char* smem0, int wv) {
  unsigned char* ws = P.ws; LAUNDER_G(ws);
  const int tid = tid_(wv), lane = tid & 63, wid = wv, r = lane & 31, hh = lane >> 5;
  const int half = wid >> 2, hw = wid & 3, ht = tid & 255;
  const int item = pair * 2 + half;
  const int n = item & 63, bh = item >> 6, b = bh >> 2, h = bh & 3;
  const int tok0 = b * 4096 + n * 64, col0 = h * 64;
  const float* LF = (const float*)(ws + O_LF); const bf16_t* QH = (const bf16_t*)(ws + O_QH); const bf16_t* KH = (const bf16_t*)(ws + O_KH);
  const bf16_t* VH = (const bf16_t*)(ws + O_VH); const bf16_t* GS = (const bf16_t*)(ws + O_GS);
  unsigned char* smem = smem0 + half * 65536;
  float* sB = (float*)smem;
  float* sSeg = (float*)(smem + 16640);
  bf16_t* sA = (bf16_t*)(smem + 18944);
  bf16_t* sQ = (bf16_t*)(smem + 28160);
  bf16_t* sVt = (bf16_t*)(smem + 37376);
  bf16_t* sS = (bf16_t*)(smem + 46592);
  bf16_t* sP = (bf16_t*)(smem + 55808);
  const int k = ht & 63, seg = wv & 3;
  __syncthreads();
  unsigned short gV[16], gK[16], gQ[16];
#pragma unroll
  for (int i = 0; i < 16; ++i) { const size_t o = (size_t)(tok0 + seg * 16 + i) * 256 + col0 + k; gV[i] = VH[o]; gK[i] = KH[o]; gQ[i] = (STEP == 3) ? QH[o] : (unsigned short)0; }
  u32x4 gS[2] = {{0u, 0u, 0u, 0u}, {0u, 0u, 0u, 0u}};
  if (STEP == 3) {
#pragma unroll
    for (int pp = 0; pp < 2; ++pp) { const int p = ht + 256 * pp, v = p >> 3, part = p & 7; gS[pp] = *(const u32x4*)((const bf16_t*)(ws + O_SP) + (size_t)item * 4096 + v * 64 + part * 8); }
  }
  { float v[16]; float run = 0.f;
#pragma unroll
    for (int i = 0; i < 16; ++i) v[i] = LF[(size_t)(tok0 + seg * 16 + i) * 256 + col0 + k];
#pragma unroll
    for (int i = 0; i < 16; ++i) { run += v[i]; v[i] = run; }
    sSeg[seg * 64 + k] = run; __syncthreads();
    float pre = 0.f;
#pragma unroll
    for (int s = 0; s < 4; ++s) if (s < seg) pre += sSeg[s * 64 + k];
#pragma unroll
    for (int i = 0; i < 16; ++i) sB[(seg * 16 + i) * 65 + k] = v[i] + pre;
  }
#pragma unroll
  for (int i = 0; i < 16; ++i) { const int s = seg * 16 + i; sVt[k * 72 + s] = gV[i]; }
  __syncthreads();
  if (STEP == 1) {
    const float bl = sB[63 * 65 + k];
#pragma unroll
    for (int i = 0; i < 16; ++i) { const int s = seg * 16 + i; const float kk = bf2f(gK[i]); sA[k * 72 + s] = f2bf(kk * __expf(bl - sB[s * 65 + k])); }
    if (seg == 0) { ((float*)(ws + O_DEC))[(size_t)item * 64 + k] = __expf(bl); ((float*)(ws + O_EREF))[(size_t)item * 64 + k] = __expf(sB[31 * 65 + k]); }
    __syncthreads();
    {
      const int vb = hw >> 1, kb = hw & 1;
      f32x16 c; for (int i = 0; i < 16; ++i) c[i] = 0.f;
#pragma unroll
      for (int ks = 0; ks < 4; ++ks) {
        const bf16x8 a = *(const bf16x8*)(sVt + (32 * vb + r) * 72 + 16 * ks + 8 * hh);
        const bf16x8 bb = *(const bf16x8*)(sA + (32 * kb + r) * 72 + 16 * ks + 8 * hh);
        c = MFMA32(a, bb, c);
      }
      float* dst = (float*)(ws + O_CKVT) + (size_t)item * 4096;
#pragma unroll
      for (int i = 0; i < 16; ++i) dst[(32 * vb + crow(i, hh)) * 64 + 32 * kb + r] = c[i];
    }
  } else {
    const float br = sB[31 * 65 + k];
#pragma unroll
    for (int i = 0; i < 16; ++i) {
      const int t = seg * 16 + i; const float bt = sB[t * 65 + k];
      const float qq = bf2f(gQ[i]), kk = bf2f(gK[i]);
      sQ[t * 72 + k] = f2bf(qq * __expf(bt - br));
      sA[t * 72 + k] = f2bf(kk * __expf(br - bt));
    }
#pragma unroll
    for (int pp = 0; pp < 2; ++pp) { const int p = ht + 256 * pp, v = p >> 3, part = p & 7;
      *(u32x4*)(sS + v * 72 + part * 8) = gS[pp]; }
    __syncthreads();
    {
      const int sb = hw >> 1, tb = hw & 1;
      f32x16 c; for (int i = 0; i < 16; ++i) c[i] = 0.f;
      if (!(sb == 1 && tb == 0)) {
#pragma unroll
        for (int ks = 0; ks < 4; ++ks) {
          const bf16x8 a = *(const bf16x8*)(sA + (32 * sb + r) * 72 + 16 * ks + 8 * hh);
          const bf16x8 bb = *(const bf16x8*)(sQ + (32 * tb + r) * 72 + 16 * ks + 8 * hh);
          c = MFMA32(a, bb, c);
        }
      }
      const int t = 32 * tb + r;
#pragma unroll
      for (int g = 0; g < 4; ++g) {
        f32x4 v;
#pragma unroll
        for (int j = 0; j < 4; ++j) { const int s = 32 * sb + 8 * g + 4 * hh + j; v[j] = (s <= t) ? c[4 * g + j] : 0.f; }
        *(u32x2*)(sP + t * 72 + 32 * sb + 8 * g + 4 * hh) = pk4(v);
      }
    }
    __syncthreads();
    if (hw < 2) {
      const int tb = hw, t = 32 * tb + r;
      f32x16 c0, c1; for (int i = 0; i < 16; ++i) { c0[i] = 0.f; c1[i] = 0.f; }
#pragma unroll
      for (int ks = 0; ks < 4; ++ks) {
        const bf16x8 bp = *(const bf16x8*)(sP + t * 72 + 16 * ks + 8 * hh);
        const bf16x8 bq = *(const bf16x8*)(sQ + t * 72 + 16 * ks + 8 * hh);
        c0 = MFMA32(*(const bf16x8*)(sVt + r * 72 + 16 * ks + 8 * hh), bp, c0);
        c1 = MFMA32(*(const bf16x8*)(sVt + (32 + r) * 72 + 16 * ks + 8 * hh), bp, c1);
        c0 = MFMA32(*(const bf16x8*)(sS + r * 72 + 16 * ks + 8 * hh), bq, c0);
        c1 = MFMA32(*(const bf16x8*)(sS + (32 + r) * 72 + 16 * ks + 8 * hh), bq, c1);
      }
      float ss = 0.f;
#pragma unroll
      for (int i = 0; i < 16; ++i) ss += c0[i] * c0[i] + c1[i] * c1[i];
      ss += shx(ss, 32, lane);
      const float rn = rsqrtf(ss * (1.f / 64.f) + RMS_EPS);
      const float* ng = IN_(ws, I_HNG) + L * 256 + col0;
      bf16_t* MIX = (bf16_t*)(ws + O_MIX);
#pragma unroll
      for (int vb = 0; vb < 2; ++vb)
#pragma unroll
        for (int g = 0; g < 4; ++g) {
          const int v0 = 32 * vb + 8 * g + 4 * hh;
          const f32x4 gs = unpk4(*(const u32x2*)(GS + (size_t)(tok0 + t) * 256 + col0 + v0));
          const f32x4 nv = *(const f32x4*)(ng + v0);
          f32x4 o;
#pragma unroll
          for (int j = 0; j < 4; ++j) o[j] = (vb == 0 ? c0[4 * g + j] : c1[4 * g + j]) * rn * nv[j] * gs[j];
          *(u32x2*)(MIX + (size_t)(tok0 + t) * 1024 + col0 + v0) = pk4(o);
        }
    }
  }
  __syncthreads();
}

DI void hgrn_scan(const Params& P, int bh, int wv) {
  unsigned char* ws = P.ws; LAUNDER_G(ws);
  const int tid = tid_(wv), k = tid & 63, vq = wv;
  const float* __restrict__ DEC = (const float*)(ws + O_DEC) + (size_t)bh * 64 * 64; const float* __restrict__ EREF = (const float*)(ws + O_EREF) + (size_t)bh * 64 * 64;
  const float* __restrict__ CKVT = (const float*)(ws + O_CKVT) + (size_t)bh * 64 * 4096; bf16_t* __restrict__ SP = (bf16_t*)(ws + O_SP) + (size_t)bh * 64 * 4096;
  float S[8];
#pragma unroll
  for (int i = 0; i < 8; ++i) S[i] = 0.f;
  float dc[8], ec[8], kc[8][8];
#define SC_LOAD(D, E, K, nb_) do { _Pragma("unroll") for (int j = 0; j < 8; ++j) { const int n = (nb_) * 8 + j; D[j] = DEC[n * 64 + k]; E[j] = EREF[n * 64 + k]; \
    _Pragma("unroll") for (int i = 0; i < 8; ++i) K[j][i] = CKVT[(size_t)n * 4096 + (vq * 8 + i) * 64 + k]; } } while (0)
  SC_LOAD(dc, ec, kc, 0);
#pragma unroll 1
  for (int nb = 0; nb < 8; ++nb) {
    float dn[8], en[8], kn[8][8];
    if (nb + 1 < 8) SC_LOAD(dn, en, kn, nb + 1);
    else {
#pragma unroll
      for (int j = 0; j < 8; ++j) { dn[j] = 0.f; en[j] = 0.f;
#pragma unroll
        for (int i = 0; i < 8; ++i) kn[j][i] = 0.f; }
    }
#pragma unroll
    for (int j = 0; j < 8; ++j) {
      const int n = nb * 8 + j;
#pragma unroll
      for (int i = 0; i < 8; ++i) { SP[(size_t)n * 4096 + (vq * 8 + i) * 64 + k] = f2bf(ec[j] * S[i]); S[i] = dc[j] * S[i] + kc[j][i]; }
    }
#pragma unroll
    for (int j = 0; j < 8; ++j) { dc[j] = dn[j]; ec[j] = en[j];
#pragma unroll
      for (int i = 0; i < 8; ++i) kc[j][i] = kn[j][i]; }
  }
#undef SC_LOAD
}

constexpr int AT_KB = 26624, AT_VB = 17408, AT_VOFF = 2 * AT_KB;
DI void attn_unit(const Params& P, int bh, int qb, unsigned char* smem, int wv) {
  unsigned char* ws = P.ws; LAUNDER_G(ws);
  const int tid = tid_(wv), lane = tid & 63, wid = wv, r = lane & 31, hh = lane >> 5;
  const int sq = 256 * qb + 32 * wid + r;
  const bf16_t* QF = (const bf16_t*)(ws + O_QF); const bf16_t* kbase = (const bf16_t*)(ws + O_KF) + (size_t)bh * 4096 * 96;
  const bf16_t* vbase = (const bf16_t*)(ws + O_VT) + (size_t)bh * 4096 * 64;
  bf16x8 qf[6];
  { const bf16_t* qp = QF + ((size_t)bh * 4096 + sq) * 96 + 8 * hh;
#pragma unroll
    for (int ds = 0; ds < 6; ++ds) qf[ds] = *(const bf16x8*)(qp + 16 * ds); }
  f32x16 o0, o1; for (int i = 0; i < 16; ++i) { o0[i] = 0.f; o1[i] = 0.f; }
  float mrun = 0.f, lrun = 0.f;
  const int nt = 2 * qb + 2, ktmax = 2 * qb + (wid >> 2);
  int kr[3], kc[3];
#pragma unroll
  for (int i = 0; i < 3; ++i) { const int p = tid + 512 * i; kr[i] = p / 12; kc[i] = p - 12 * kr[i]; }
  const int vkey = tid & 127, vpart = tid >> 7;
  const int vkp = (vkey & ~15) | ((vkey & 3) | ((vkey & 4) << 1) | ((vkey & 8) >> 1));
  u32x4 rk[3], rv[2];
#define AT_GLOAD(kt) do { const bf16_t* kp = kbase + (size_t)(kt) * 128 * 96; _Pragma("unroll") for (int i = 0; i < 3; ++i) rk[i] = *(const u32x4*)(kp + kr[i] * 96 + kc[i] * 8); \
    _Pragma("unroll") for (int i = 0; i < 2; ++i) rv[i] = *(const u32x4*)(vbase + (size_t)((kt) * 128 + vkey) * 64 + (vpart + 4 * i) * 8); } while (0)
#define AT_SWRITE(buf) do { unsigned char* kd = smem + (buf) * AT_KB; _Pragma("unroll") for (int i = 0; i < 3; ++i) *(u32x4*)(kd + kr[i] * 208 + kc[i] * 16) = rk[i]; \
    _Pragma("unroll") for (int i = 0; i < 2; ++i) { bf16_t* vd = (bf16_t*)(smem + AT_VOFF + (buf) * AT_VB) + ((vpart + 4 * i) * 8) * 136 + vkp; \
      vd[0] = (bf16_t)(rv[i][0] & 0xffffu); vd[136] = (bf16_t)(rv[i][0] >> 16); vd[272] = (bf16_t)(rv[i][1] & 0xffffu); vd[408] = (bf16_t)(rv[i][1] >> 16); \
      vd[544] = (bf16_t)(rv[i][2] & 0xffffu); vd[680] = (bf16_t)(rv[i][2] >> 16); vd[816] = (bf16_t)(rv[i][3] & 0xffffu); vd[952] = (bf16_t)(rv[i][3] >> 16); } } while (0)
  __syncthreads();
  AT_GLOAD(0); AT_SWRITE(0); __syncthreads();
#pragma unroll 1
  for (int kt = 0; kt < nt; ++kt) {
    const int cur = kt & 1;
    if (kt + 1 < nt) AT_GLOAD(kt + 1);
    if (kt <= ktmax) {
      const unsigned char* Kb = smem + cur * AT_KB; const unsigned char* Vb = smem + AT_VOFF + cur * AT_VB;
      const int nkb = (kt == ktmax) ? (wid & 3) + 1 : 4;
      f32x16 p[4];
      const float ninit = -mrun;
      f32x16 cinit; for (int i = 0; i < 16; ++i) cinit[i] = ninit;
      if (kt != ktmax) {
#pragma unroll
        for (int kb = 0; kb < 4; ++kb) p[kb] = MFMA32(*(const bf16x8*)(Kb + (32 * kb + r) * 208 + hh * 16), qf[0], cinit);
#pragma unroll
        for (int ds = 1; ds < 6; ++ds)
#pragma unroll
          for (int kb = 0; kb < 4; ++kb) p[kb] = MFMA32(*(const bf16x8*)(Kb + (32 * kb + r) * 208 + ds * 32 + hh * 16), qf[ds], p[kb]);
      } else
#pragma unroll
      for (int kb = 0; kb < 4; ++kb) {
        if (kb < nkb) {
          p[kb] = MFMA32(*(const bf16x8*)(Kb + (32 * kb + r) * 208 + hh * 16), qf[0], cinit);
#pragma unroll
          for (int ds = 1; ds < 6; ++ds) p[kb] = MFMA32(*(const bf16x8*)(Kb + (32 * kb + r) * 208 + ds * 32 + hh * 16), qf[ds], p[kb]);
          if (kt == ktmax && kb == nkb - 1) {
            const int lim = sq - 128 * kt - 32 * kb - 4 * hh;
#pragma unroll
            for (int i = 0; i < 16; ++i) if ((i & 3) + 8 * (i >> 2) > lim) p[kb][i] = -INFINITY;
          }
        }
      }
      float mx = p[0][0];
#pragma unroll
      for (int kb = 0; kb < 4; ++kb) if (kb < nkb) {
#pragma unroll
        for (int i = 0; i < 16; ++i) mx = fmaxf(mx, p[kb][i]); }
      mx = fmaxf(mx, shx(mx, 32, lane));
      if (kt == 0 || __builtin_amdgcn_ballot_w64(mx > 8.f) != 0ull) {
        const float delta = (kt == 0) ? mx : fmaxf(mx, 0.f);
        const float alpha = (kt == 0) ? 0.f : __builtin_amdgcn_exp2f(-delta);
        mrun += delta; lrun *= alpha;
#pragma unroll
        for (int i = 0; i < 16; ++i) { o0[i] *= alpha; o1[i] *= alpha; }
#pragma unroll
        for (int kb = 0; kb < 4; ++kb)
#pragma unroll
          for (int i = 0; i < 16; ++i) p[kb][i] -= delta;
      }
      f32x2 ls2 = {0.f, 0.f};
#pragma unroll
      for (int kb = 0; kb < 4; ++kb) if (kb < nkb) {
#pragma unroll
        for (int i = 0; i < 16; ++i) p[kb][i] = __builtin_amdgcn_exp2f(p[kb][i]);
#pragma unroll
        for (int i = 0; i < 16; i += 2) { f32x2 t2; t2[0] = p[kb][i]; t2[1] = p[kb][i + 1]; ls2 += t2; }
#pragma unroll
        for (int s2 = 0; s2 < 2; ++s2) {
          u32x4 pw;
#pragma unroll
          for (int j = 0; j < 4; ++j) pw[j] = pk2(p[kb][8 * s2 + 2 * j], p[kb][8 * s2 + 2 * j + 1]);
          const bf16x8 pb = __builtin_bit_cast(bf16x8, pw);
          const int vfo = (32 * kb + 16 * s2 + 8 * hh) * 2;
          o0 = MFMA32(*(const bf16x8*)(Vb + r * 272 + vfo), pb, o0);
          o1 = MFMA32(*(const bf16x8*)(Vb + (32 + r) * 272 + vfo), pb, o1);
        }
      }
      lrun += ls2[0] + ls2[1];
    }
    if (kt + 1 < nt) AT_SWRITE(cur ^ 1);
    __syncthreads();
  }
#undef AT_GLOAD
#undef AT_SWRITE
  lrun += shx(lrun, 32, lane);
  const float inv = 1.f / lrun;
  const int b = bh >> 3, h = bh & 7;
  bf16_t* op = (bf16_t*)(ws + O_MIX) + (size_t)(b * 4096 + sq) * 1024 + 512 + h * 64;
#pragma unroll
  for (int g = 0; g < 4; ++g) {
    f32x4 a, c;
#pragma unroll
    for (int j = 0; j < 4; ++j) { a[j] = o0[4 * g + j] * inv; c[j] = o1[4 * g + j] * inv; }
    *(u32x2*)(op + 8 * g + 4 * hh) = pk4(a); *(u32x2*)(op + 32 + 8 * g + 4 * hh) = pk4(c);
  }
}

#define XB_TMO      128
#define XB_XCNT(j)  (256  + 64 * (j))
#define XB_XSUB(j)  (1280 + 64 * (j))
#define XB_XGEN(j)  (2304 + 64 * (j))
#define XB_TOP      3328
#define XB_TOPGEN   3392
#define XCD_BAR_WORDS 3456
#define XB_SPIN_CAP (1u << 18)
constexpr size_t O_BAR = 256 * 1024;
constexpr int LDS_XB = 143360;
DI unsigned xb_ld(unsigned* p)              { return __hip_atomic_load(p, __ATOMIC_RELAXED, __HIP_MEMORY_SCOPE_AGENT); }
DI unsigned xb_add(unsigned* p, unsigned v) { return __hip_atomic_fetch_add(p, v, __ATOMIC_RELAXED, __HIP_MEMORY_SCOPE_AGENT); }
DI unsigned xb_xcc_id() { return (unsigned)__builtin_amdgcn_s_getreg((3 << 11) | 20) & 0xFu; }
#define XB_SPIN(cond, bar) do { unsigned _sp = 0; while (cond) { __builtin_amdgcn_s_sleep(1); \
    if ((++_sp & 255u) == 0u) { if (xb_ld(&(bar)[XB_TMO])) break; if (_sp > XB_SPIN_CAP) { atomicAdd(&(bar)[XB_TMO], 1u); break; } } } } while (0)
DI void xcd_barrier_complete(unsigned* bar, unsigned x, unsigned G, unsigned& nloc, unsigned& nx) {
    unsigned sum, cnt, mine, sp = 0u;
    for (;;) {
        sum = 0u; cnt = 0u; mine = 0u;
#pragma unroll
        for (unsigned j = 0; j < 16; ++j) { const unsigned c = xb_ld(&bar[XB_XCNT(j)]); sum += c; cnt += (c > 0u) ? 1u : 0u; mine = (j == x) ? c : mine; }
        if (sum == G) break;
        __builtin_amdgcn_s_sleep(1);
        if ((++sp & 255u) == 0u) { if (xb_ld(&bar[XB_TMO])) break; if (sp > XB_SPIN_CAP) { atomicAdd(&bar[XB_TMO], 1u); break; } }
    }
    nloc = mine > 0u ? mine : 1u; nx = cnt > 0u ? cnt : 1u;
}
DI void xcd_barrier(unsigned char* ws, unsigned char* smem, int wv) {
    asm volatile("s_waitcnt vmcnt(0)" ::: "memory");
    __syncthreads();
    if (tid_(wv) == 0) {
        unsigned* bar = (unsigned*)(ws + O_BAR); const unsigned x = xb_xcc_id(); volatile LAS unsigned* st = (volatile LAS unsigned*)(smem + LDS_XB);
        __builtin_amdgcn_s_waitcnt(0);
        unsigned nloc = st[0], nx = st[1];
        if (nloc == 0u) { xcd_barrier_complete(bar, x, (unsigned)nblk_(), nloc, nx); st[0] = nloc; st[1] = nx; }
        const unsigned old = xb_add(&bar[XB_XSUB(x)], 1u);
        const unsigned gen = old / nloc;
        if (old + 1u == (gen + 1u) * nloc) {
            __builtin_amdgcn_fence(__ATOMIC_RELEASE, "agent");
            asm volatile("s_waitcnt vmcnt(0)" ::: "memory");
            const unsigned og = xb_add(&bar[XB_TOP], 1u);
            const unsigned tg = og / nx;
            if (og + 1u == (tg + 1u) * nx) xb_add(&bar[XB_TOPGEN], 1u);
            else XB_SPIN(xb_ld(&bar[XB_TOPGEN]) == tg, bar);
            __builtin_amdgcn_fence(__ATOMIC_ACQUIRE, "agent");
            xb_add(&bar[XB_XGEN(x)], 1u);
            asm volatile("s_waitcnt vmcnt(0)" ::: "memory");
        } else {
            XB_SPIN(xb_ld(&bar[XB_XGEN(x)]) == gen, bar);
            __builtin_amdgcn_fence(__ATOMIC_ACQUIRE, "agent");
            asm volatile("s_waitcnt vmcnt(0)" ::: "memory");
        }
    }
    __syncthreads();
}

__global__ void __launch_bounds__(512, 2) fwd_megakernel(Params P) {
  extern __shared__ __attribute__((aligned(16))) unsigned char smem[];
  cg::grid_group grid = cg::this_grid();
  unsigned char* ws = (unsigned char*)(GAS unsigned char*)P.ws;
  const int wv = __builtin_amdgcn_readfirstlane((int)(threadIdx.x >> 6));
  if (tid_(wv) == 0) { volatile LAS unsigned* st = (volatile LAS unsigned*)(smem + LDS_XB); st[0] = 0u; st[1] = 0u; (void)xb_add((unsigned*)(ws + O_BAR) + XB_XCNT(xb_xcc_id()), 1u); }
  { const int tid = tid_(wv); const float** tab = (const float**)(P.ws + O_TAB + (size_t)bid_() * 256);
    if (tid == 0) {
      tab[0] = P.in[0]; tab[1] = P.in[1]; tab[2] = P.in[2]; tab[3] = P.in[3]; tab[4] = P.in[4]; tab[5] = P.in[5]; tab[6] = P.in[6]; tab[7] = P.in[7]; tab[8] = P.in[8]; tab[9] = P.in[9]; tab[10] = P.in[10]; tab[11] = P.in[11]; tab[12] = P.in[12]; tab[13] = P.in[13]; tab[14] = P.in[14]; tab[15] = P.in[15]; tab[16] = P.in[16]; tab[17] = P.in[17]; tab[18] = P.in[18]; tab[19] = P.in[19]; tab[20] = P.in[20]; tab[21] = P.in[21]; tab[22] = P.in[22]; tab[23] = P.in[23]; tab[24] = P.in[24];
      tab[25] = P.out; }
    __threadfence(); __syncthreads(); }
#pragma unroll 1
  for (int L = 0; L < 2; ++L) {
    for (int rep = 0; rep < REP_P0; ++rep) { if (rep) xcd_barrier(ws, smem, wv);
    PH(0) phase0(P, L, smem, wv); }
    if (nblk_() == 0) grid.sync();
    xcd_barrier(ws, smem, wv);
#ifdef EXTRA_SYNC
    for (int e = 0; e < EXTRA_SYNC; ++e) xcd_barrier(ws, smem, wv);
#endif
    PH(1) { unsigned char* w = ws; LAUNDER_G(w); EpiProj E(P, w, L, smem);
      run_gemm(smem, (const bf16_t*)(w + O_AB), (const bf16_t*)(w + O_WIN), T, INP, 1024, E, wv); }
    xcd_barrier(ws, smem, wv);
#if defined(PROBE_P1)
    { unsigned char* w = ws; LAUNDER_G(w); EpiProj_<false> E(P, w, L, smem);
      run_gemm(smem, (const bf16_t*)(w + O_AB), (const bf16_t*)(w + O_WIN), T, INP, 1024, E, wv); }
#endif
    PH(2) { unsigned char* w = ws; LAUNDER_G(w); EpiQ E; E.ws = w; E.L = L; E.smem = smem;
      run_gemm(smem, (const bf16_t*)(w + O_CQ), (const bf16_t*)(w + O_WUQ), T, 768, 384, E, wv); }
    PH(3) { unsigned char* w = ws; LAUNDER_G(w); EpiKV E; E.ws = w; E.L = L; E.smem = smem;
      run_gemm(smem, (const bf16_t*)(w + O_CKV), (const bf16_t*)(w + O_WUKV), T, 1024, 256, E, wv); }
    for (int rep = 0; rep < REP_SMALL; ++rep) {
    PH(4) for (int it = bid_(); it < 512; it += nblk_()) sgu_item(P, L, it, smem, wv);
    PH(5) for (int it = bid_(); it < 512; it += nblk_()) hgrn_item<1>(P, L, it, smem, wv); }
    xcd_barrier(ws, smem, wv);
    for (int rep = 0; rep < REP_ATTN; ++rep) { if (rep) xcd_barrier(ws, smem, wv);
    PH(6) { int* cnt = (int*)(ws + O_CNT) + L + 2 * rep; int* slot = (int*)(smem + 143360 + 64); const int tid = tid_(wv);
      for (;;) {
        __syncthreads();
        if (tid == 0) *slot = atomicAdd(cnt, 1);
        __syncthreads();
        const int it = *slot;
        if (it >= 16 + 512) break;
        if (it < 16) hgrn_scan(P, it, wv);
        else { const int idx = it - 16; attn_unit(P, idx & 31, 15 - (idx >> 5), smem, wv); }
      } } }
    xcd_barrier(ws, smem, wv);
    for (int rep = 0; rep < REP_SMALL; ++rep)
    PH(7) for (int it = bid_(); it < 512; it += nblk_()) hgrn_item<3>(P, L, it, smem, wv);
    xcd_barrier(ws, smem, wv);
    PH(8) { unsigned char* w = ws; LAUNDER_G(w); EpiOut E(P, w, L, smem);
      run_gemm(smem, (const bf16_t*)(w + O_MIX), (const bf16_t*)(w + O_WOUT), T, 1024, 1024, E, wv); }
    PH(9) { unsigned char* w = ws; LAUNDER_G(w); EpiPle E; E.ws = w;
      run_gemm(smem, (const bf16_t*)(w + O_PB), (const bf16_t*)(w + O_WPP), T, 1024, 256, E, wv); }
    xcd_barrier(ws, smem, wv);
    PH(10) { unsigned char* w = ws; LAUNDER_G(w); EpiGU E; E.ws = w; E.L = L; E.smem = smem;
      run_gemm(smem, (const bf16_t*)(w + O_AB), (const bf16_t*)(w + O_WGU), T, NGU, 1024, E, wv); }
    xcd_barrier(ws, smem, wv);
#if defined(PROBE_GU) && PROBE_GU == 1
    { unsigned char* w = ws; LAUNDER_G(w); EpiNull E;
      run_gemm(smem, (const bf16_t*)(w + O_AB), (const bf16_t*)(w + O_WGU), T, 2 * DFF, 1024, E, wv); }
#elif defined(PROBE_GU) && PROBE_GU >= 2
    { unsigned char* w = ws; LAUNDER_G(w); EpiGU_<PROBE_GU - 1> E; E.ws = w; E.L = L; E.smem = smem;
      run_gemm(smem, (const bf16_t*)(w + O_AB), (const bf16_t*)(w + O_WGU), T, 2 * DFF, 1024, E, wv); }
#endif
    PH(11) { unsigned char* w = ws; LAUNDER_G(w); EpiDown E(P, w, L, smem);
      run_gemm(smem, (const bf16_t*)(w + O_ACT), (const bf16_t*)(w + O_WDN), T, 1024, DFF, E, wv); }
    xcd_barrier(ws, smem, wv);
  }
  { const float* st = (const float*)(ws + O_STAT + 2 * STAT_BYTES); const float* g = IN_(ws, I_LN2G) + 1024; const float* b = IN_(ws, I_LN2B) + 1024;
    float* outp = OUT_(ws);
    const int tid = tid_(wv); const int nth = nblk_() * 512;
    for (int i0 = bid_() * 512 + tid; i0 < T * 256; i0 += nth * 8) {
      const int c = (i0 & 255) * 4;
      const f32x4 gv = *(const GAS f32x4*)(g + c), bv = *(const GAS f32x4*)(b + c);
      f32x4 z[8]; float sm[8], sq[8];
#pragma unroll
      for (int k = 0; k < 8; ++k) { const int i = i0 + k * nth; const int row = (i < T * 256 ? i : i0) >> 8;
        z[k] = __builtin_nontemporal_load((const GAS f32x4*)(outp + (size_t)row * 1024 + c)); sm[k] = st[(size_t)row * 8]; sq[k] = st[(size_t)row * 8 + 1]; }
#pragma unroll
      for (int k = 0; k < 8; ++k) { const int i = i0 + k * nth;
        if (i < T * 256) { const float mean = sm[k] * (1.f / 1024.f), rstd = rsqrtf(fmaxf(sq[k] * (1.f / 1024.f) - mean * mean, 0.f) + LN_EPS);
          __builtin_nontemporal_store((z[k] - mean) * rstd * gv + bv, (GAS f32x4*)(outp + (size_t)(i >> 8) * 1024 + c)); } }
    } }
}

extern "C" void kernel_launch(void* const* d_in, const int* in_sizes, int n_in, void* d_out, int out_size, void* d_ws, size_t ws_size, hipStream_t stream) {
  static int grid_blocks = 0;
  if (grid_blocks == 0) {
    if (n_in != 25 || ws_size < WS_NEED) { fprintf(stderr, "kernel_launch: unexpected n_in %d or ws_size %zu\n", n_in, ws_size); grid_blocks = -1; return; }
    int dev = 0, cus = 0, per_cu = 0;
    hipGetDevice(&dev);
    hipDeviceGetAttribute(&cus, hipDeviceAttributeMultiprocessorCount, dev);
    if (hipFuncSetAttribute((const void*)fwd_megakernel, hipFuncAttributeMaxDynamicSharedMemorySize, LDS_BYTES) != hipSuccess) { fprintf(stderr, "kernel_launch: hipFuncSetAttribute failed\n"); }
    if (hipOccupancyMaxActiveBlocksPerMultiprocessor(&per_cu, (const void*)fwd_megakernel, 512, LDS_BYTES) != hipSuccess || per_cu < 1) { fprintf(stderr, "kernel_launch: occupancy query says %d\n", per_cu); per_cu = 1; }
    (void)hipGetLastError();
    grid_blocks = cus * 1;
    if (grid_blocks > 256) grid_blocks = 256;
  }
  if (grid_blocks < 0) return;
  if (hipMemsetAsync((char*)d_ws + O_BAR, 0, XCD_BAR_WORDS * 4, stream) != hipSuccess) { fprintf(stderr, "kernel_launch: memset failed\n"); return; }
  Params p{};
  for (int i = 0; i < 25; ++i) p.in[i] = (const float*)d_in[i];
  p.out = (float*)d_out; p.ws = (unsigned char*)d_ws;
  void* args[] = {&p};
  hipError_t e = hipLaunchCooperativeKernel((const void*)fwd_megakernel, dim3(grid_blocks), dim3(512), args, LDS_BYTES, stream);
  if (e != hipSuccess) fprintf(stderr, "cooperative launch failed: %s (grid %d)\n", hipGetErrorString(e), grid_blocks);
}
```
